# Optimizing an MI355X kernel written in HIP

```python
import math
import numpy as np
import jax
import jax.numpy as jnp
from jax import lax

D_MODEL = 2048
BATCH = 4
SEQ = 2048
DEPTH = 1

HEAD_DIM = 128
N_FOX_HEADS = 8
N_NSA_HEADS = 8
N_NSA_KV_HEADS = 2
NSA_GROUP = N_NSA_HEADS // N_NSA_KV_HEADS
FOX_WIDTH = N_FOX_HEADS * HEAD_DIM
NSA_WIDTH = N_NSA_HEADS * HEAD_DIM
NSA_KV_WIDTH = N_NSA_KV_HEADS * HEAD_DIM
MIX_WIDTH = FOX_WIDTH + NSA_WIDTH
N_BRANCH = 3
CMP_BLOCK = 32
CMP_STRIDE = 16
SEL_BLOCK = 64
N_SEL = 8
WINDOW = 512
Q_BLOCK = 128
N_BUCKETS = 32
MAX_DISTANCE = 128
D_FF = -(-(8 * D_MODEL) // (3 * 256)) * 256
N_MOD = 6
IN_SPLITS = (FOX_WIDTH, FOX_WIDTH, FOX_WIDTH, N_FOX_HEADS, NSA_WIDTH,
             N_BRANCH * NSA_KV_WIDTH, N_BRANCH * NSA_KV_WIDTH, N_BRANCH * N_NSA_HEADS)
IN_WIDTH = 3 * FOX_WIDTH + N_FOX_HEADS + NSA_WIDTH + 2 * N_BRANCH * NSA_KV_WIDTH + N_BRANCH * N_NSA_HEADS
SCALE = HEAD_DIM ** -0.5
EPS = 1e-6
NEG = -1e30
FORCE = 1e6

kernel_name = 'hymba_fox_nsa_adaln_block'


def rms_norm(x, gain):
    xf = x.astype(jnp.float32)
    y = xf * lax.rsqrt(jnp.mean(xf * xf, axis=-1, keepdims=True) + EPS)
    return (y * gain.astype(jnp.float32)).astype(x.dtype)


def masked_softmax(logits, valid):
    p = jax.nn.softmax(jnp.where(valid, logits, NEG), axis=-1)
    return jnp.where(valid, p, 0.0)


def t5_bucket(dist):
    n = jnp.maximum(dist, 0)
    max_exact = N_BUCKETS // 2
    nf = jnp.maximum(n, 1).astype(jnp.float32)
    large = max_exact + (jnp.log(nf / max_exact) / math.log(MAX_DISTANCE / max_exact)
                         * (N_BUCKETS - max_exact)).astype(jnp.int32)
    large = jnp.minimum(large, N_BUCKETS - 1)
    return jnp.where(n < max_exact, n, large)


def to_blocks(a):
    b, s = a.shape[:2]
    return jnp.moveaxis(a.reshape(b, s // Q_BLOCK, Q_BLOCK, *a.shape[2:]), 1, 0)


def from_blocks(a):
    nb, b, qb = a.shape[:3]
    return jnp.moveaxis(a, 0, 1).reshape(b, nb * qb, *a.shape[3:])


def forgetting_attention(q, k, v, f_logit, f_bias):
    b, s = q.shape[:2]
    log_f = jax.nn.log_sigmoid(f_logit.astype(jnp.float32) + f_bias.astype(jnp.float32))
    cum = jnp.cumsum(log_f, axis=1)
    cum_k = jnp.transpose(cum, (0, 2, 1))
    kpos = jnp.arange(s)

    def one_block(args):
        qb, cq, q0 = args
        qpos = q0 + jnp.arange(Q_BLOCK)
        logits = jnp.einsum('bqhd,bkhd->bhqk', qb, k).astype(jnp.float32) * SCALE
        logits = logits + jnp.transpose(cq, (0, 2, 1))[..., None] - cum_k[:, :, None, :]
        p = masked_softmax(logits, kpos[None, :] <= qpos[:, None])
        return jnp.einsum('bhqk,bkhd->bqhd', p.astype(v.dtype), v)

    starts = jnp.arange(s // Q_BLOCK, dtype=jnp.int32) * Q_BLOCK
    return from_blocks(lax.map(one_block, (to_blocks(q), to_blocks(cum), starts)))


def compress_blocks(kv, pos_emb, w1, w2):
    b, s = kv.shape[:2]
    n_cmp = (s - CMP_BLOCK) // CMP_STRIDE + 1
    idx = np.arange(n_cmp)[:, None] * CMP_STRIDE + np.arange(CMP_BLOCK)[None, :]
    blocks = kv[:, idx] + pos_emb[None, None, :, None, :]
    flat = jnp.transpose(blocks, (0, 1, 3, 2, 4)).reshape(b, n_cmp, N_NSA_KV_HEADS, CMP_BLOCK * HEAD_DIM)
    return jax.nn.silu(flat @ w1) @ w2


def selection_matrix(n_cmp, n_slc):
    r, q = SEL_BLOCK // CMP_STRIDE, CMP_BLOCK // CMP_STRIDE
    tgt = (r * np.arange(n_slc)[:, None, None] + np.arange(r)[None, :, None]
           - np.arange(q)[None, None, :]).reshape(n_slc, -1)
    return (np.arange(n_cmp)[:, None, None] == tgt[None]).sum(-1).astype(np.float32)


def native_sparse_attention(q, k_br, v_br, gates, k_gain, cmp_pos, cmp_w1, cmp_w2, rel_bias):
    b, s = q.shape[:2]
    hkv, grp = N_NSA_KV_HEADS, NSA_GROUP
    kc = rms_norm(compress_blocks(k_br[:, :, 0], cmp_pos[0], cmp_w1[0], cmp_w2[0]), k_gain[0])
    vc = compress_blocks(v_br[:, :, 0], cmp_pos[1], cmp_w1[1], cmp_w2[1])
    k_slc = rms_norm(k_br[:, :, 1], k_gain[1])
    k_win = rms_norm(k_br[:, :, 2], k_gain[2])
    n_cmp = kc.shape[1]
    n_slc = s // SEL_BLOCK
    top_n = min(N_SEL, n_slc)
    cmp_end = jnp.arange(n_cmp) * CMP_STRIDE + CMP_BLOCK - 1
    sel_m = jnp.asarray(selection_matrix(n_cmp, n_slc))
    ksb = k_slc.reshape(b, n_slc, SEL_BLOCK, hkv, HEAD_DIM).transpose(0, 3, 1, 2, 4)
    vsb = v_br[:, :, 1].reshape(b, n_slc, SEL_BLOCK, hkv, HEAD_DIM).transpose(0, 3, 1, 2, 4)
    pad = ((0, 0), (WINDOW, 0), (0, 0), (0, 0))
    kw = jnp.pad(k_win, pad)
    vw = jnp.pad(v_br[:, :, 2], pad)
    tb = rel_bias.reshape(N_BUCKETS, hkv, grp)
    b_ix = jnp.arange(b)[:, None, None, None]
    h_ix = jnp.arange(hkv)[None, None, :, None]
    blk_ids = jnp.arange(n_slc)

    def one_block(args):
        qb, gb, q0 = args
        qpos = q0 + jnp.arange(Q_BLOCK)
        qg = qb.reshape(b, Q_BLOCK, hkv, grp, HEAD_DIM)
        d_c = qpos[:, None] - cmp_end[None, :]
        s_c = jnp.einsum('bqhgd,bchd->bqhgc', qg, kc).astype(jnp.float32) * SCALE
        s_c = s_c + tb[t5_bucket(d_c)].transpose(0, 2, 3, 1)
        p_c = masked_softmax(s_c, (d_c >= 0)[:, None, None, :])
        o_c = jnp.einsum('bqhgc,bchd->bqhgd', p_c.astype(vc.dtype), vc)
        imp = jnp.einsum('bqhc,cj->bqhj', p_c.sum(axis=3), sel_m)
        cur = (qpos // SEL_BLOCK)[:, None]
        forced = (blk_ids[None, :] == 0) | (blk_ids[None, :] == cur) | (blk_ids[None, :] == cur - 1)
        imp = jnp.where(forced[None, :, None, :], FORCE, imp)
        imp = jnp.where((blk_ids[None, :] <= cur)[None, :, None, :], imp, -jnp.inf)
        top_s, top_i = lax.top_k(imp, top_n)
        ks = ksb[b_ix, h_ix, top_i].reshape(b, Q_BLOCK, hkv, top_n * SEL_BLOCK, HEAD_DIM)
        vs = vsb[b_ix, h_ix, top_i].reshape(b, Q_BLOCK, hkv, top_n * SEL_BLOCK, HEAD_DIM)
        spos = (top_i[..., None] * SEL_BLOCK + jnp.arange(SEL_BLOCK)).reshape(b, Q_BLOCK, hkv, -1)
        d_s = qpos[None, :, None, None] - spos
        valid_s = (d_s >= 0) & jnp.repeat(jnp.isfinite(top_s), SEL_BLOCK, axis=-1)
        s_s = jnp.einsum('bqhgd,bqhkd->bqhgk', qg, ks).astype(jnp.float32) * SCALE
        s_s = s_s + tb[t5_bucket(d_s), h_ix].transpose(0, 1, 2, 4, 3)
        p_s = masked_softmax(s_s, valid_s[:, :, :, None, :])
        o_s = jnp.einsum('bqhgk,bqhkd->bqhgd', p_s.astype(vs.dtype), vs)
        kwb = lax.dynamic_slice_in_dim(kw, q0, WINDOW + Q_BLOCK, axis=1)
        vwb = lax.dynamic_slice_in_dim(vw, q0, WINDOW + Q_BLOCK, axis=1)
        wpos = q0 - WINDOW + jnp.arange(WINDOW + Q_BLOCK)
        d_w = qpos[:, None] - wpos[None, :]
        valid_w = (d_w >= 0) & (d_w < WINDOW) & (wpos[None, :] >= 0)
        s_w = jnp.einsum('bqhgd,bkhd->bqhgk', qg, kwb).astype(jnp.float32) * SCALE
        s_w = s_w + tb[t5_bucket(d_w)].transpose(0, 2, 3, 1)
        p_w = masked_softmax(s_w, valid_w[:, None, None, :])
        o_w = jnp.einsum('bqhgk,bkhd->bqhgd', p_w.astype(vwb.dtype), vwb)
        g = gb.reshape(b, Q_BLOCK, hkv, grp, N_BRANCH)
        o = g[..., 0:1] * o_c + g[..., 1:2] * o_s + g[..., 2:3] * o_w
        return o.reshape(b, Q_BLOCK, N_NSA_HEADS, HEAD_DIM)

    starts = jnp.arange(s // Q_BLOCK, dtype=jnp.int32) * Q_BLOCK
    return from_blocks(lax.map(one_block, (to_blocks(q), to_blocks(gates), starts)))


def setup_inputs(seed: int = 0) -> dict:
    key = jax.random.key(seed)
    ks = jax.random.split(key, 20)
    nrm = lambda k, shape, sc: jax.random.normal(k, shape, jnp.float32) * sc
    gain = lambda k, shape: 1.0 + 0.02 * jax.random.normal(k, shape, jnp.float32)
    return {
        'x': nrm(ks[0], (BATCH, SEQ, D_MODEL), 1.0),
        'c': nrm(ks[1], (BATCH, D_MODEL), 1.0),
        'ada_w': nrm(ks[2], (DEPTH, D_MODEL, N_MOD * D_MODEL), 0.02),
        'ada_b': nrm(ks[3], (DEPTH, N_MOD * D_MODEL), 0.02),
        'norm1_gain': gain(ks[4], (DEPTH, D_MODEL)),
        'norm2_gain': gain(ks[5], (DEPTH, D_MODEL)),
        'w_in': nrm(ks[6], (DEPTH, D_MODEL, IN_WIDTH), D_MODEL ** -0.5),
        'fox_f_bias': jax.random.uniform(ks[7], (DEPTH, N_FOX_HEADS), jnp.float32, 1.0, 4.0),
        'fox_q_gain': gain(ks[8], (DEPTH, HEAD_DIM)),
        'fox_k_gain': gain(ks[9], (DEPTH, HEAD_DIM)),
        'nsa_q_gain': gain(ks[10], (DEPTH, HEAD_DIM)),
        'nsa_k_gain': gain(ks[11], (DEPTH, N_BRANCH, HEAD_DIM)),
        'nsa_cmp_pos': nrm(ks[12], (DEPTH, 2, CMP_BLOCK, HEAD_DIM), 0.1),
        'nsa_cmp_w1': nrm(ks[13], (DEPTH, 2, CMP_BLOCK * HEAD_DIM, HEAD_DIM), (CMP_BLOCK * HEAD_DIM) ** -0.5),
        'nsa_cmp_w2': nrm(ks[14], (DEPTH, 2, HEAD_DIM, HEAD_DIM), HEAD_DIM ** -0.5),
        'rel_bias': nrm(ks[15], (N_BUCKETS, N_NSA_HEADS), 0.1),
        'mix_out_gain': gain(ks[16], (DEPTH, MIX_WIDTH)),
        'w_out': nrm(ks[17], (DEPTH, MIX_WIDTH, D_MODEL), MIX_WIDTH ** -0.5),
        'ffn_w_gate': nrm(ks[18], (DEPTH, D_MODEL, D_FF), D_MODEL ** -0.5),
        'ffn_w_up': nrm(jax.random.fold_in(ks[18], 1), (DEPTH, D_MODEL, D_FF), D_MODEL ** -0.5),
        'ffn_w_down': nrm(ks[19], (DEPTH, D_FF, D_MODEL), D_FF ** -0.5),
    }


def reference(x, c, ada_w, ada_b, norm1_gain, norm2_gain, w_in, fox_f_bias, fox_q_gain, fox_k_gain,
              nsa_q_gain, nsa_k_gain, nsa_cmp_pos, nsa_cmp_w1, nsa_cmp_w2, rel_bias, mix_out_gain,
              w_out, ffn_w_gate, ffn_w_up, ffn_w_down):
    b, s = x.shape[:2]
    split_points = np.cumsum(IN_SPLITS)[:-1].tolist()
    for layer in range(DEPTH):
        mod = (jax.nn.silu(c) @ ada_w[layer] + ada_b[layer])[:, None, :]
        sh1, sc1, g1, sh2, sc2, g2 = jnp.split(mod, N_MOD, axis=-1)
        h = rms_norm(x, norm1_gain[layer]) * (1 + sc1) + sh1
        proj = h @ w_in[layer]
        fq, fk, fv, ff, nq, nk, nv, ng = jnp.split(proj, split_points, axis=-1)
        fq = rms_norm(fq.reshape(b, s, N_FOX_HEADS, HEAD_DIM), fox_q_gain[layer])
        fk = rms_norm(fk.reshape(b, s, N_FOX_HEADS, HEAD_DIM), fox_k_gain[layer])
        fv = fv.reshape(b, s, N_FOX_HEADS, HEAD_DIM)
        o_fox = forgetting_attention(fq, fk, fv, ff, fox_f_bias[layer])
        nq = rms_norm(nq.reshape(b, s, N_NSA_HEADS, HEAD_DIM), nsa_q_gain[layer])
        nk = nk.reshape(b, s, N_BRANCH, N_NSA_KV_HEADS, HEAD_DIM)
        nv = nv.reshape(b, s, N_BRANCH, N_NSA_KV_HEADS, HEAD_DIM)
        ng = jax.nn.sigmoid(ng.reshape(b, s, N_NSA_HEADS, N_BRANCH))
        o_nsa = native_sparse_attention(nq, nk, nv, ng, nsa_k_gain[layer], nsa_cmp_pos[layer],
                                        nsa_cmp_w1[layer], nsa_cmp_w2[layer], rel_bias)
        y = jnp.concatenate([
            rms_norm(o_fox.reshape(b, s, FOX_WIDTH), mix_out_gain[layer, :FOX_WIDTH]),
            rms_norm(o_nsa.reshape(b, s, NSA_WIDTH), mix_out_gain[layer, FOX_WIDTH:]),
        ], axis=-1)
        x = x + g1 * (y @ w_out[layer])
        h2 = rms_norm(x, norm2_gain[layer]) * (1 + sc2) + sh2
        ffn = (jax.nn.silu(h2 @ ffn_w_gate[layer]) * (h2 @ ffn_w_up[layer])) @ ffn_w_down[layer]
        x = x + g2 * ffn
    return x
```

```cpp
#define NAIVE_BUILD 1
#include <hip/hip_runtime.h>
#include <cstdint>
#include <cstdio>

#define GAS __attribute__((address_space(1)))
#define LAS __attribute__((address_space(3)))
typedef _Float16 f16;
typedef _Float16 h8 __attribute__((ext_vector_type(8)));
typedef _Float16 h4 __attribute__((ext_vector_type(4)));
typedef _Float16 h2 __attribute__((ext_vector_type(2)));
typedef float f32x2 __attribute__((ext_vector_type(2)));
typedef float f32x4 __attribute__((ext_vector_type(4)));
typedef float f32x16 __attribute__((ext_vector_type(16)));
typedef unsigned u32x2 __attribute__((ext_vector_type(2)));
typedef unsigned u32x4 __attribute__((ext_vector_type(4)));

constexpr int NB = 4, SEQ = 2048, DM = 2048, NTOK = NB * SEQ, HD = 128;
constexpr int NFH = 8, NNH = 8, NKV = 2, GRP = 4;
constexpr int INW = 5664, NP = 5888, DFF = 5632, NGU = 2 * DFF, NMOD = 6 * DM;
constexpr int NCMP = 127, NSLC = 32, NSEL = 8, WIN = 512;
constexpr int C_FQ = 0, C_FK = 1024, C_FV = 2048, C_NQ = 3072, C_NK = 4096, C_NV = 4864, C_FF = 5632, C_NG = 5640;
constexpr float SCALE = 0.08838834764831845f, EPS = 1e-6f, LOG2E = 1.4426950408889634f;

constexpr size_t MiB = 1u << 20;
constexpr size_t WS_CTL = 0, CTL_BYTES = 1 * MiB;
constexpr size_t WS_MODP = 1 * MiB;
constexpr size_t WS_MOD = 2 * MiB;
constexpr size_t WS_CUM = 2 * MiB + 256 * 1024;
constexpr size_t WS_KC = 2 * MiB + 512 * 1024;
constexpr size_t WS_VC = 2 * MiB + 768 * 1024;
constexpr size_t WS_TBL = 3 * MiB;
constexpr size_t WS_B1 = 3 * MiB + 16 * 1024;
constexpr size_t WS_W2T = 3 * MiB + 64 * 1024;
constexpr size_t WS_W1T = 4 * MiB;
constexpr size_t WS_SEL = 6 * MiB;
constexpr size_t WS_WIN = 8 * MiB;
constexpr size_t WS_WOUT = 31 * MiB;
constexpr size_t WS_WGU = 39 * MiB;
constexpr size_t WS_WDN = 83 * MiB;
constexpr size_t WS_H = 105 * MiB;
constexpr size_t WS_PROJ = 137 * MiB;
constexpr size_t WS_OF = 229 * MiB, WS_OC = 245 * MiB, WS_OS = 261 * MiB, WS_OW = 277 * MiB;
constexpr size_t WS_SCR = 293 * MiB;
constexpr size_t WS_END = 325 * MiB;

struct Args {
    const float* in[21];
    float* out;
    unsigned char* ws;
    int ph_lo, ph_hi, li, pad;
};
enum { I_X = 0, I_C, I_ADAW, I_ADAB, I_G1, I_G2, I_WIN, I_FB, I_FQG, I_FKG, I_NQG, I_NKG, I_POS, I_W1, I_W2, I_RB, I_MOG, I_WOUT, I_WG, I_WU, I_WD };

__device__ __forceinline__ float wave_sum(float v) {
#pragma unroll
    for (int o = 1; o < 64; o <<= 1) v += __shfl_xor(v, o);
    return v;
}
__device__ __forceinline__ float silu_f(float x) { return x / (1.f + __expf(-x)); }
__device__ __forceinline__ float sigmoid_f(float x) { return 1.f / (1.f + __expf(-x)); }
__device__ __forceinline__ int t5_bucket(int d) {
    if (d < 16) return d < 0 ? 0 : d;
    const int thr[15] = {19, 21, 24, 27, 31, 35, 40, 46, 52, 59, 67, 77, 87, 99, 113};
    int b = 16;
#pragma unroll
    for (int i = 0; i < 15; ++i) b += (d >= thr[i]) ? 1 : 0;
    return b;
}
__device__ __forceinline__ int win_src_col(int n) {
    if (n < 3072) return n;
    if (n < 4096) return 3080 + (n - 3072);
    if (n < 4864) return 4104 + (n - 4096);
    if (n < 5632) return 4872 + (n - 4864);
    if (n < 5640) return 3072 + (n - 5632);
    if (n < 5664) return n;
    return -1;
}
constexpr int NT = 512, NWV = 8;

__device__ __forceinline__ void transpose_item(const float* W, const float* W2, int Nsrc, int K, f16* WT, int mode, LAS float* scr, int kb, int nb, int lane) {
    const int k0 = 64 * kb, n0 = 32 * nb;
    const int nl = n0 + (lane & 31);
    int sc; const float* src = W;
    if (mode == 0) sc = win_src_col(nl);
    else if (mode == 1) sc = nl;
    else { const int p = nl >> 8, r = nl & 255; sc = 128 * p + (r & 127); src = (r < 128) ? W : W2; }
#pragma unroll 8
    for (int i = 0; i < 32; ++i) { const int kk = 2 * i + (lane >> 5); scr[kk * 33 + (lane & 31)] = (sc >= 0) ? src[(size_t)(k0 + kk) * Nsrc + sc] : 0.f; }
    asm volatile("s_waitcnt lgkmcnt(0)" ::: "memory");
    const int c = lane & 7;
#pragma unroll
    for (int j = 0; j < 4; ++j) { const int n = (lane >> 3) + 8 * j; const LAS float* s = scr + (8 * c) * 33 + n;
        h8 o;
#pragma unroll
        for (int i = 0; i < 8; ++i) o[i] = (f16)s[i * 33];
        *(h8*)(WT + (size_t)(n0 + n) * K + k0 + 8 * c) = o; }
    asm volatile("s_waitcnt lgkmcnt(0)" ::: "memory");
}

__device__ __forceinline__ void stage_prep(const Args& a, int bid, int nblk, LAS char* lds) {
    const int tid = threadIdx.x, lane = tid & 63, wave = __builtin_amdgcn_readfirstlane(tid >> 6);
    unsigned char* ws = a.ws;
    {
        LAS float* scr = (LAS float*)(lds + wave * 8448);
        f16* WIN_T = (f16*)(ws + WS_WIN); f16* WOUT_T = (f16*)(ws + WS_WOUT); f16* WGU_T = (f16*)(ws + WS_WGU); f16* WDN_T = (f16*)(ws + WS_WDN);
        f16* W1T = (f16*)(ws + WS_W1T); f16* W2T = (f16*)(ws + WS_W2T);
        constexpr int I_IN = 32 * (NP / 32), I_OUT = 32 * (DM / 32), I_GU = 32 * (NGU / 32), I_DN = (DFF / 64) * (DM / 32), I_1 = 2 * 64 * 4, I_2 = 2 * 2 * 4;
        constexpr int NIT = I_IN + I_OUT + I_GU + I_DN + I_1 + I_2;
        const int gw = bid * NWV + wave, ngw = nblk * NWV;
        for (int it = gw; it < NIT; it += ngw) {
            int r = it;
            if (r < I_IN) { transpose_item(a.in[I_WIN], nullptr, INW, DM, WIN_T, 0, scr, r / (NP / 32), r % (NP / 32), lane); continue; } r -= I_IN;
            if (r < I_OUT) { transpose_item(a.in[I_WOUT], nullptr, DM, DM, WOUT_T, 1, scr, r / (DM / 32), r % (DM / 32), lane); continue; } r -= I_OUT;
            if (r < I_GU) { transpose_item(a.in[I_WG], a.in[I_WU], DFF, DM, WGU_T, 2, scr, r / (NGU / 32), r % (NGU / 32), lane); continue; } r -= I_GU;
            if (r < I_DN) { transpose_item(a.in[I_WD], nullptr, DM, DFF, WDN_T, 1, scr, r / (DM / 32), r % (DM / 32), lane); continue; } r -= I_DN;
            if (r < I_1) { const int wh = r / 256, q = r % 256; transpose_item(a.in[I_W1] + (size_t)wh * 4096 * 128, nullptr, 128, 4096, W1T + (size_t)wh * 128 * 4096, 1, scr, q / 4, q % 4, lane); continue; } r -= I_1;
            { const int wh = r / 8, q = r % 8; transpose_item(a.in[I_W2] + (size_t)wh * 128 * 128, nullptr, 128, 128, W2T + (size_t)wh * 128 * 128, 1, scr, q / 4, q % 4, lane); }
        }
    }
    __syncthreads();
    {
        LAS float* sc = (LAS float*)lds;
        LAS float* red = (LAS float*)(lds + 8192);
        float* MODP = (float*)(ws + WS_MODP);
        const float* cin = a.in[I_C]; const float* W = a.in[I_ADAW];
        const int tx = tid & 15, ty = tid >> 4;
        for (int it = bid; it < 192 * 4; it += nblk) {
            const int cc = it % 192, kc = it / 192, col0 = cc * 64, kbase = kc * 512;
            for (int i = tid; i < 4 * 512; i += NT) { const int b = i >> 9, k = i & 511; sc[i] = silu_f(cin[b * DM + kbase + k]); }
            __syncthreads();
            f32x4 acc[4] = {};
#pragma unroll 4
            for (int p = 0; p < 16; ++p) { const int kl = p * 32 + ty; const f32x4 w = *(const f32x4*)(W + (size_t)(kbase + kl) * NMOD + col0 + tx * 4);
#pragma unroll
                for (int b = 0; b < 4; ++b) acc[b] += w * sc[b * 512 + kl]; }
#pragma unroll
            for (int b = 0; b < 4; ++b) *(LAS f32x4*)(red + (ty * 4 + b) * 64 + tx * 4) = acc[b];
            __syncthreads();
            if (tid < 256) { const int b = tid >> 6, c = tid & 63; float s = 0.f;
#pragma unroll 8
                for (int y = 0; y < 32; ++y) s += red[(y * 4 + b) * 64 + c];
                MODP[((size_t)kc * 4 + b) * NMOD + col0 + c] = s; }
            __syncthreads();
        }
    }
    if (bid == 0) {
        float* TBL = (float*)(ws + WS_TBL); const float* rb = a.in[I_RB];
        for (int i = tid; i < 8 * 128; i += NT) { const int h = i >> 7, d = i & 127; const float v = rb[t5_bucket(d) * 8 + h]; TBL[i] = v; TBL[1024 + i] = v - rb[31 * 8 + h]; }
    }
    for (int wh = bid; wh < 2; wh += nblk) {
        LAS float* red = (LAS float*)lds;
        const float* pos = a.in[I_POS] + wh * 4096; const float* w1 = a.in[I_W1] + (size_t)wh * 4096 * 128;
        const int n = tid & 127, q = tid >> 7; float s = 0.f;
        for (int k = q; k < 4096; k += 4) s += pos[k] * w1[(size_t)k * 128 + n];
        red[q * 128 + n] = s; __syncthreads();
        if (tid < 128) ((float*)(ws + WS_B1))[wh * 128 + tid] = red[tid] + red[128 + tid] + red[256 + tid] + red[384 + tid];
        __syncthreads();
    }
}

__device__ __forceinline__ void stage_norm(const Args& a, int bid, int nblk, LAS char* lds, int which) {
    const int tid = threadIdx.x, lane = tid & 63, wave = __builtin_amdgcn_readfirstlane(tid >> 6);
    unsigned char* ws = a.ws;
    const float* MODP = (const float*)(ws + WS_MODP); float* MOD = (float*)(ws + WS_MOD);
    const float* ada_b = a.in[I_ADAB];
    if (which == 0) {
        for (int i = bid * NT + tid; i < 4 * NMOD; i += nblk * NT) { const int n = i % NMOD;
            MOD[i] = MODP[i] + MODP[4 * NMOD + i] + MODP[8 * NMOD + i] + MODP[12 * NMOD + i] + ada_b[n]; }
    }
    const float* X = which == 0 ? a.in[I_X] : a.out; const float* gain = a.in[which == 0 ? I_G1 : I_G2];
    f16* H = (f16*)(ws + WS_H);
    LAS float* A_ = (LAS float*)lds; LAS float* B_ = (LAS float*)(lds + 8192);
    const int sh_off = which == 0 ? 0 : 3 * DM, sc_off = sh_off + DM;
    int cur_b = -1;
    for (int rb = bid; rb < NTOK / 32; rb += nblk) {
        const int b = rb / (SEQ / 32);
        if (b != cur_b) { __syncthreads();
            for (int k = tid; k < DM; k += NT) { float sc, sh;
                if (which == 0) { sc = ada_b[sc_off + k]; sh = ada_b[sh_off + k];
#pragma unroll
                    for (int kc = 0; kc < 4; ++kc) { sc += MODP[((size_t)kc * 4 + b) * NMOD + sc_off + k]; sh += MODP[((size_t)kc * 4 + b) * NMOD + sh_off + k]; } }
                else { sc = MOD[b * NMOD + sc_off + k]; sh = MOD[b * NMOD + sh_off + k]; }
                A_[k] = gain[k] * (1.f + sc); B_[k] = sh; }
            __syncthreads(); cur_b = b; }
#pragma unroll 1
        for (int rr = 0; rr < 4; ++rr) {
            const int m = rb * 32 + wave * 4 + rr;
            const f32x4* xr = (const f32x4*)(X + (size_t)m * DM);
            f32x4 v[8]; float ss = 0.f;
#pragma unroll
            for (int j = 0; j < 8; ++j) { v[j] = xr[j * 64 + lane]; ss += v[j].x * v[j].x + v[j].y * v[j].y + v[j].z * v[j].z + v[j].w * v[j].w; }
            const float r = rsqrtf(wave_sum(ss) * (1.f / DM) + EPS);
#pragma unroll
            for (int j = 0; j < 8; ++j) { const int k = j * 256 + lane * 4; const f32x4 aa = *(LAS f32x4*)(A_ + k), bb = *(LAS f32x4*)(B_ + k);
                h4 o; o.x = (f16)(v[j].x * r * aa.x + bb.x); o.y = (f16)(v[j].y * r * aa.y + bb.y); o.z = (f16)(v[j].z * r * aa.z + bb.z); o.w = (f16)(v[j].w * r * aa.w + bb.w);
                *(h4*)(H + (size_t)m * DM + k) = o; }
        }
    }
}

__device__ __forceinline__ void post_norms(const Args& a, int bid, int nblk) {
    const int tid = threadIdx.x, lane = tid & 63, wave = __builtin_amdgcn_readfirstlane(tid >> 6);
    f16* PROJ = (f16*)(a.ws + WS_PROJ);
    const int g = lane >> 4, l16 = lane & 15;
    for (int m = bid * NWV + wave; m < NTOK; m += nblk * NWV) {
        f16* row = PROJ + (size_t)m * NP;
#pragma unroll 1
        for (int it = 0; it < 7; ++it) {
            const int v = it * 4 + g; int col; const float* gn;
            if (v < 8) { col = C_FQ + v * 128; gn = a.in[I_FQG]; }
            else if (v < 16) { col = C_FK + (v - 8) * 128; gn = a.in[I_FKG]; }
            else if (v < 24) { col = C_NQ + (v - 16) * 128; gn = a.in[I_NQG]; }
            else { const int br = 1 + ((v - 24) >> 1), kvh = (v - 24) & 1; col = C_NK + br * 256 + kvh * 128; gn = a.in[I_NKG] + br * 128; }
            h8 x = *(h8*)(row + col + l16 * 8); float f[8]; float ss = 0.f;
#pragma unroll
            for (int i = 0; i < 8; ++i) { f[i] = (float)x[i]; ss += f[i] * f[i]; }
            ss += __shfl_xor(ss, 1); ss += __shfl_xor(ss, 2); ss += __shfl_xor(ss, 4); ss += __shfl_xor(ss, 8);
            const float r = rsqrtf(ss * (1.f / 128.f) + EPS);
#pragma unroll
            for (int i = 0; i < 8; ++i) x[i] = (f16)(f[i] * r * gn[l16 * 8 + i]);
            *(h8*)(row + col + l16 * 8) = x;
        }
    }
}
__device__ __forceinline__ void post_cumsum(const Args& a, int bid, int nblk) {
    const int tid = threadIdx.x, lane = tid & 63, wave = __builtin_amdgcn_readfirstlane(tid >> 6);
    const f16* PROJ = (const f16*)(a.ws + WS_PROJ); float* CUM = (float*)(a.ws + WS_CUM);
    for (int s = bid * NWV + wave; s < NB * NFH; s += nblk * NWV) {
        const int b = s >> 3, h = s & 7; const float fb = a.in[I_FB][h];
        float v[32]; float run = 0.f;
#pragma unroll
        for (int i = 0; i < 32; ++i) { const int t = lane * 32 + i; const float x = (float)PROJ[(size_t)(b * SEQ + t) * NP + C_FF + h] + fb;
            const float ls = fminf(x, 0.f) - log1pf(__expf(-fabsf(x))); run += ls; v[i] = run; }
        float incl = run;
#pragma unroll
        for (int o = 1; o < 64; o <<= 1) { const float n = __shfl_up(incl, o); if (lane >= o) incl += n; }
        const float excl = incl - run;
#pragma unroll
        for (int i = 0; i < 32; ++i) CUM[(size_t)s * SEQ + lane * 32 + i] = v[i] + excl;
    }
}

__device__ __forceinline__ void stage_ynorm(const Args& a, int bid, int nblk) {
    const int tid = threadIdx.x, lane = tid & 63, wave = __builtin_amdgcn_readfirstlane(tid >> 6);
    unsigned char* ws = a.ws;
    const f16* OF = (const f16*)(ws + WS_OF); const f16* OC = (const f16*)(ws + WS_OC); const f16* OS = (const f16*)(ws + WS_OS); const f16* OW = (const f16*)(ws + WS_OW);
    const f16* PROJ = (const f16*)(ws + WS_PROJ); f16* Y = (f16*)(ws + WS_H); const float* mog = a.in[I_MOG];
    for (int m = bid * NWV + wave; m < NTOK; m += nblk * NWV) {
        float f[16], n[16]; float ssf = 0.f, ssn = 0.f;
        const size_t o16 = (size_t)m * 1024 + lane * 16;
        const int hd = lane >> 3;
        const f16* gp = PROJ + (size_t)m * NP + C_NG + hd * 3;
        const float g0 = sigmoid_f((float)gp[0]), g1 = sigmoid_f((float)gp[1]), g2 = sigmoid_f((float)gp[2]);
#pragma unroll
        for (int hh = 0; hh < 2; ++hh) {
            const h8 xf = *(const h8*)(OF + o16 + hh * 8), xc = *(const h8*)(OC + o16 + hh * 8), xs = *(const h8*)(OS + o16 + hh * 8), xw = *(const h8*)(OW + o16 + hh * 8);
#pragma unroll
            for (int i = 0; i < 8; ++i) { f[hh * 8 + i] = (float)xf[i]; n[hh * 8 + i] = g0 * (float)xc[i] + g1 * (float)xs[i] + g2 * (float)xw[i];
                ssf += f[hh * 8 + i] * f[hh * 8 + i]; ssn += n[hh * 8 + i] * n[hh * 8 + i]; }
        }
        const float rf = rsqrtf(wave_sum(ssf) * (1.f / 1024.f) + EPS), rn = rsqrtf(wave_sum(ssn) * (1.f / 1024.f) + EPS);
#pragma unroll
        for (int hh = 0; hh < 2; ++hh) { h8 of, on;
#pragma unroll
            for (int i = 0; i < 8; ++i) { const int k = lane * 16 + hh * 8 + i; of[i] = (f16)(f[hh * 8 + i] * rf * mog[k]); on[i] = (f16)(n[hh * 8 + i] * rn * mog[1024 + k]); }
            *(h8*)(Y + (size_t)m * DM + lane * 16 + hh * 8) = of; *(h8*)(Y + (size_t)m * DM + 1024 + lane * 16 + hh * 8) = on; }
    }
}
#if NAIVE_BUILD
template <int MODE> __global__ void __launch_bounds__(256) naive_gemm(Args a) {
    unsigned char* ws = a.ws;
    const int tx = threadIdx.x & 15, ty = threadIdx.x >> 4;
    const int n0 = blockIdx.x * 64 + tx * 4, m0 = blockIdx.y * 64 + ty * 4;
    const f16* A; const f16* Bt; int K;
    if (MODE == 0) { A = (const f16*)(ws + WS_H); Bt = (const f16*)(ws + WS_WIN); K = DM; }
    else if (MODE == 1) { A = (const f16*)(ws + WS_H); Bt = (const f16*)(ws + WS_WOUT); K = DM; }
    else if (MODE == 2) { A = (const f16*)(ws + WS_H); Bt = (const f16*)(ws + WS_WGU); K = DM; }
    else { A = (const f16*)(ws + WS_PROJ); Bt = (const f16*)(ws + WS_WDN); K = DFF; }
    int brow[4], urow[4];
#pragma unroll
    for (int j = 0; j < 4; ++j) { const int n = n0 + j;
        if (MODE == 2) { brow[j] = 256 * (n >> 7) + (n & 127); urow[j] = brow[j] + 128; } else { brow[j] = n; urow[j] = n; } }
    float acc[4][4] = {}, accu[4][4] = {};
    for (int k = 0; k < K; k += 8) {
        h8 av[4], bv[4], uv[4];
#pragma unroll
        for (int i = 0; i < 4; ++i) av[i] = *(const h8*)(A + (size_t)(m0 + i) * K + k);
#pragma unroll
        for (int j = 0; j < 4; ++j) { bv[j] = *(const h8*)(Bt + (size_t)brow[j] * K + k); if (MODE == 2) uv[j] = *(const h8*)(Bt + (size_t)urow[j] * K + k); }
#pragma unroll
        for (int e = 0; e < 8; ++e)
#pragma unroll
            for (int i = 0; i < 4; ++i)
#pragma unroll
                for (int j = 0; j < 4; ++j) { acc[i][j] += (float)av[i][e] * (float)bv[j][e]; if (MODE == 2) accu[i][j] += (float)av[i][e] * (float)uv[j][e]; }
    }
    const float* MOD = (const float*)(ws + WS_MOD);
#pragma unroll
    for (int i = 0; i < 4; ++i) { const int m = m0 + i, b = m / SEQ;
#pragma unroll
        for (int j = 0; j < 4; ++j) { const int n = n0 + j;
            if (MODE == 0) ((f16*)(ws + WS_PROJ))[(size_t)m * NP + n] = (f16)acc[i][j];
            else if (MODE == 1) a.out[(size_t)m * DM + n] = a.in[I_X][(size_t)m * DM + n] + MOD[b * NMOD + 2 * DM + n] * acc[i][j];
            else if (MODE == 2) ((f16*)(ws + WS_PROJ))[(size_t)m * DFF + n] = (f16)(silu_f(acc[i][j]) * accu[i][j]);
            else a.out[(size_t)m * DM + n] = a.out[(size_t)m * DM + n] + MOD[b * NMOD + 5 * DM + n] * acc[i][j]; } }
}

__device__ __forceinline__ void row_step(bool valid, float bias, const h8 (&q)[16], const f16* krow, const f16* vrow, float& m, float& l, float (&o)[128]) {
    float s = 0.f;
#pragma unroll
    for (int c = 0; c < 16; ++c) { const h8 kv = *(const h8*)(krow + c * 8);
#pragma unroll
        for (int e = 0; e < 8; ++e) s += (float)q[c][e] * (float)kv[e]; }
    s = s * SCALE + bias;
    if (valid) {
        const float mn = fmaxf(m, s), al = __expf(m - mn), p = __expf(s - mn);
        l = l * al + p; m = mn;
#pragma unroll
        for (int c = 0; c < 16; ++c) { const h8 vv = *(const h8*)(vrow + c * 8);
#pragma unroll
            for (int e = 0; e < 8; ++e) o[c * 8 + e] = o[c * 8 + e] * al + p * (float)vv[e]; }
    }
}
__device__ __forceinline__ void row_store(f16* dst, float l, const float (&o)[128]) {
    const float inv = l > 0.f ? 1.f / l : 0.f;
#pragma unroll
    for (int c = 0; c < 16; ++c) { h8 w;
#pragma unroll
        for (int e = 0; e < 8; ++e) w[e] = (f16)(o[c * 8 + e] * inv);
        *(h8*)(dst + c * 8) = w; }
}

__global__ void __launch_bounds__(256) naive_fox(Args a) {
    unsigned char* ws = a.ws; const f16* PROJ = (const f16*)(ws + WS_PROJ); const float* CUM = (const float*)(ws + WS_CUM);
    const int tb = blockIdx.x & 7, h = (blockIdx.x >> 3) & 7, b = blockIdx.x >> 6, t = tb * 256 + threadIdx.x;
    h8 q[16];
#pragma unroll
    for (int c = 0; c < 16; ++c) q[c] = *(const h8*)(PROJ + (size_t)(b * SEQ + t) * NP + C_FQ + h * 128 + c * 8);
    const float* cum = CUM + (size_t)(b * 8 + h) * SEQ; const float cq = cum[t];
    float m = -1e30f, l = 0.f; float o[128];
#pragma unroll
    for (int i = 0; i < 128; ++i) o[i] = 0.f;
    const int jmax = tb * 256 + 255;
    for (int j = 0; j <= jmax; ++j) {
        const f16* kr = PROJ + (size_t)(b * SEQ + j) * NP + C_FK + h * 128; const f16* vr = PROJ + (size_t)(b * SEQ + j) * NP + C_FV + h * 128;
        row_step(j <= t, cq - cum[j], q, kr, vr, m, l, o);
    }
    row_store((f16*)(ws + WS_OF) + (size_t)(b * SEQ + t) * 1024 + h * 128, l, o);
}
__global__ void __launch_bounds__(256) naive_cmp(Args a) {
    unsigned char* ws = a.ws; const f16* PROJ = (const f16*)(ws + WS_PROJ); const float* TBL = (const float*)(ws + WS_TBL);
    const int tb = blockIdx.x & 7, h = (blockIdx.x >> 3) & 7, b = blockIdx.x >> 6, t = tb * 256 + threadIdx.x, kvh = h >> 2;
    const f16* KC = (const f16*)(ws + WS_KC) + (size_t)(b * 2 + kvh) * 128 * 128; const f16* VC = (const f16*)(ws + WS_VC) + (size_t)(b * 2 + kvh) * 128 * 128;
    float* PC = (float*)(ws + WS_SCR) + ((size_t)(b * SEQ + t) * 8 + h) * 128;
    h8 q[16];
#pragma unroll
    for (int c = 0; c < 16; ++c) q[c] = *(const h8*)(PROJ + (size_t)(b * SEQ + t) * NP + C_NQ + h * 128 + c * 8);
    float m = -1e30f, l = 0.f; float o[128];
#pragma unroll
    for (int i = 0; i < 128; ++i) o[i] = 0.f;
    for (int c = 0; c < NCMP; ++c) { const int d = t - (16 * c + 31); const int dd = d < 0 ? 0 : (d > 127 ? 127 : d);
        row_step(d >= 0, TBL[h * 128 + dd], q, KC + c * 128, VC + c * 128, m, l, o); }
    row_store((f16*)(ws + WS_OC) + (size_t)(b * SEQ + t) * 1024 + h * 128, l, o);
    const float inv = l > 0.f ? 1.f / l : 0.f;
    for (int c = 0; c < 128; ++c) { const int d = t - (16 * c + 31); float p = 0.f;
        if (c < NCMP && d >= 0) { const int dd = d > 127 ? 127 : d; float s = 0.f;
#pragma unroll
            for (int cc = 0; cc < 16; ++cc) { const h8 kv = *(const h8*)(KC + c * 128 + cc * 8);
#pragma unroll
                for (int e = 0; e < 8; ++e) s += (float)q[cc][e] * (float)kv[e]; }
            p = __expf(s * SCALE + TBL[h * 128 + dd] - m) * inv; }
        PC[c] = p; }
}
__device__ __forceinline__ unsigned topk_mask(const float (&impin)[32], int t) {
    float v[32]; const int cur = t >> 6;
#pragma unroll
    for (int j = 0; j < 32; ++j) { float x = impin[j]; if (j == 0 || j == cur || j == cur - 1) x = 1e6f; if (j > cur) x = -__builtin_inff(); v[j] = x; }
    unsigned mask = 0u;
#pragma unroll 1
    for (int it = 0; it < NSEL; ++it) { float best = -__builtin_inff(); int bi = -1;
#pragma unroll
        for (int j = 0; j < 32; ++j) if (v[j] > best) { best = v[j]; bi = j; }
        if (bi < 0) break;
        mask |= 1u << bi;
#pragma unroll
        for (int j = 0; j < 32; ++j) if (j == bi) v[j] = -__builtin_inff(); }
    return mask;
}
__global__ void __launch_bounds__(256) naive_topk(Args a) {
    unsigned char* ws = a.ws;
    const int idx = blockIdx.x * 256 + threadIdx.x; if (idx >= NTOK * 2) return;
    const int tok = idx >> 1, kvh = idx & 1, t = tok & (SEQ - 1);
    const float* PC = (const float*)(ws + WS_SCR) + ((size_t)tok * 8 + kvh * 4) * 128;
    float imp[32];
#pragma unroll
    for (int j = 0; j < 32; ++j) { float s = 0.f;
#pragma unroll
        for (int hh = 0; hh < 4; ++hh) { const float* p = PC + hh * 128;
            if (j > 0) s += p[4 * j - 1];
            s += 2.f * (p[4 * j] + p[4 * j + 1] + p[4 * j + 2]); if (4 * j + 3 < NCMP) s += p[4 * j + 3]; }
        imp[j] = s; }
    ((unsigned*)(ws + WS_SEL))[idx] = topk_mask(imp, t);
}
__global__ void __launch_bounds__(256) naive_selwin(Args a) {
    unsigned char* ws = a.ws; const f16* PROJ = (const f16*)(ws + WS_PROJ); const float* TBL = (const float*)(ws + WS_TBL);
    const int tb = blockIdx.x & 7, h = (blockIdx.x >> 3) & 7, b = blockIdx.x >> 6, t = tb * 256 + threadIdx.x, kvh = h >> 2;
    h8 q[16];
#pragma unroll
    for (int c = 0; c < 16; ++c) q[c] = *(const h8*)(PROJ + (size_t)(b * SEQ + t) * NP + C_NQ + h * 128 + c * 8);
    const unsigned mask = ((const unsigned*)(ws + WS_SEL))[(size_t)(b * SEQ + t) * 2 + kvh];
    float o[128];
    {
        float m = -1e30f, l = 0.f;
#pragma unroll
        for (int i = 0; i < 128; ++i) o[i] = 0.f;
        const int jmax = (tb * 256 + 255) >> 6;
        for (int j = 0; j <= jmax; ++j) { const bool sel = (mask >> j) & 1u;
            if (!__any(sel)) continue;
            for (int i = 0; i < 64; ++i) { const int s = j * 64 + i; const int d = t - s; const int dd = d < 0 ? 0 : (d > 127 ? 127 : d);
                const f16* kr = PROJ + (size_t)(b * SEQ + s) * NP + C_NK + 256 + kvh * 128; const f16* vr = PROJ + (size_t)(b * SEQ + s) * NP + C_NV + 256 + kvh * 128;
                row_step(sel && d >= 0, TBL[h * 128 + dd], q, kr, vr, m, l, o); } }
        row_store((f16*)(ws + WS_OS) + (size_t)(b * SEQ + t) * 1024 + h * 128, l, o);
    }
    {
        float m = -1e30f, l = 0.f;
#pragma unroll
        for (int i = 0; i < 128; ++i) o[i] = 0.f;
        int s0 = tb * 256 - (WIN - 1); if (s0 < 0) s0 = 0; const int s1 = tb * 256 + 255;
        for (int s = s0; s <= s1; ++s) { const int d = t - s; const int dd = d < 0 ? 0 : (d > 127 ? 127 : d);
            const f16* kr = PROJ + (size_t)(b * SEQ + s) * NP + C_NK + 512 + kvh * 128; const f16* vr = PROJ + (size_t)(b * SEQ + s) * NP + C_NV + 512 + kvh * 128;
            row_step(d >= 0 && d < WIN, TBL[h * 128 + dd], q, kr, vr, m, l, o); }
        row_store((f16*)(ws + WS_OW) + (size_t)(b * SEQ + t) * 1024 + h * 128, l, o);
    }
}
__global__ void __launch_bounds__(128) naive_compress(Args a) {
    unsigned char* ws = a.ws; const f16* PROJ = (const f16*)(ws + WS_PROJ);
    __shared__ float hid[128]; __shared__ float red[2];
    const int c = blockIdx.x & 127, kvh = (blockIdx.x >> 7) & 1, b = (blockIdx.x >> 8) & 3, wh = blockIdx.x >> 10, n = threadIdx.x;
    f16* dst = (f16*)(ws + (wh == 0 ? WS_KC : WS_VC)) + ((size_t)(b * 2 + kvh) * 128 + c) * 128;
    if (c >= NCMP) { dst[n] = (f16)0.f; return; }
    const float* w1 = a.in[I_W1] + (size_t)wh * 4096 * 128; const float* w2 = a.in[I_W2] + (size_t)wh * 128 * 128; const float* pos = a.in[I_POS] + wh * 4096;
    const int col = (wh == 0 ? C_NK : C_NV) + kvh * 128;
    float s = 0.f;
    for (int l = 0; l < 32; ++l) { const f16* xr = PROJ + (size_t)(b * SEQ + 16 * c + l) * NP + col;
        for (int d = 0; d < 128; ++d) s += ((float)xr[d] + pos[l * 128 + d]) * w1[(size_t)(l * 128 + d) * 128 + n]; }
    hid[n] = silu_f(s); __syncthreads();
    float o = 0.f;
    for (int k = 0; k < 128; ++k) o += hid[k] * w2[k * 128 + n];
    if (wh == 0) { float ss = wave_sum(o * o); if ((n & 63) == 0) red[n >> 6] = ss; __syncthreads(); ss = red[0] + red[1];
        o = o * rsqrtf(ss * (1.f / 128.f) + EPS) * a.in[I_NKG][n]; }
    dst[n] = (f16)o;
}
#endif
constexpr int LDS_BYTES = 147456;

__global__ void __launch_bounds__(NT, 2) k_stage(Args a, int stage) {
    extern __shared__ __attribute__((aligned(16))) unsigned char lds_raw[];
    LAS char* lds = (LAS char*)lds_raw;
    const int bid = blockIdx.x, nblk = gridDim.x;
    if (stage == 0) stage_prep(a, bid, nblk, lds);
    else if (stage == 1) stage_norm(a, bid, nblk, lds, 0);
    else if (stage == 3) { post_norms(a, bid, nblk); post_cumsum(a, bid, nblk); }
    else if (stage == 5) stage_ynorm(a, bid, nblk);
    else if (stage == 7) stage_norm(a, bid, nblk, lds, 1);
}

extern "C" void kernel_launch(void* const* d_in, const int* in_sizes, int n_in, void* d_out, int out_size, void* d_ws, size_t ws_size, hipStream_t stream) {
    static int grid = 0;
    if (grid == 0) {
        if (n_in != 21 || out_size != NTOK * DM || ws_size < WS_END) { fprintf(stderr, "kernel_launch: unexpected problem (n_in %d out %d ws %zu)\n", n_in, out_size, ws_size); grid = -1; return; }
        int dev = 0, cus = 0;
        hipGetDevice(&dev); hipDeviceGetAttribute(&cus, hipDeviceAttributeMultiprocessorCount, dev);
        hipFuncSetAttribute((const void*)k_stage, hipFuncAttributeMaxDynamicSharedMemorySize, LDS_BYTES);
        grid = cus > 0 ? cus : 256;
    }
    if (grid < 0) return;
    hipMemsetAsync((char*)d_ws + WS_CTL, 0, CTL_BYTES, stream);
    Args a{};
    for (int i = 0; i < 21; ++i) a.in[i] = (const float*)d_in[i];
    a.out = (float*)d_out; a.ws = (unsigned char*)d_ws;
#if NAIVE_BUILD
    hipLaunchKernelGGL(k_stage, dim3(grid), dim3(NT), LDS_BYTES, stream, a, 0);
    hipLaunchKernelGGL(k_stage, dim3(grid), dim3(NT), LDS_BYTES, stream, a, 1);
    hipLaunchKernelGGL(naive_gemm<0>, dim3(NP / 64, NTOK / 64), dim3(256), 0, stream, a);
    hipLaunchKernelGGL(naive_compress, dim3(2048), dim3(128), 0, stream, a);
    hipLaunchKernelGGL(k_stage, dim3(grid), dim3(NT), LDS_BYTES, stream, a, 3);
    hipLaunchKernelGGL(naive_fox, dim3(256), dim3(256), 0, stream, a);
    hipLaunchKernelGGL(naive_cmp, dim3(256), dim3(256), 0, stream, a);
    hipLaunchKernelGGL(naive_topk, dim3(NTOK * 2 / 256), dim3(256), 0, stream, a);
    hipLaunchKernelGGL(naive_selwin, dim3(256), dim3(256), 0, stream, a);
    hipLaunchKernelGGL(k_stage, dim3(grid), dim3(NT), LDS_BYTES, stream, a, 5);
    hipLaunchKernelGGL(naive_gemm<1>, dim3(DM / 64, NTOK / 64), dim3(256), 0, stream, a);
    hipLaunchKernelGGL(k_stage, dim3(grid), dim3(NT), LDS_BYTES, stream, a, 7);
    hipLaunchKernelGGL(naive_gemm<2>, dim3(DFF / 64, NTOK / 64), dim3(256), 0, stream, a);
    hipLaunchKernelGGL(naive_gemm<3>, dim3(DM / 64, NTOK / 64), dim3(256), 0, stream, a);
#endif
}
```

```cpp
#include <hip/hip_runtime.h>
#include <cstdint>
#include <cstdio>

#define GAS __attribute__((address_space(1)))
#define LAS __attribute__((address_space(3)))
typedef _Float16 f16;
typedef _Float16 h8 __attribute__((ext_vector_type(8)));
typedef _Float16 h4 __attribute__((ext_vector_type(4)));
typedef _Float16 h2 __attribute__((ext_vector_type(2)));
typedef float f32x2 __attribute__((ext_vector_type(2)));
typedef float f32x4 __attribute__((ext_vector_type(4)));
typedef float f32x16 __attribute__((ext_vector_type(16)));
typedef unsigned u32x2 __attribute__((ext_vector_type(2)));
typedef unsigned u32x4 __attribute__((ext_vector_type(4)));

constexpr int NB = 4, SEQ = 2048, DM = 2048, NTOK = NB * SEQ, HD = 128;
constexpr int NFH = 8, NNH = 8, NKV = 2, GRP = 4;
constexpr int INW = 5664, NP = 5888, DFF = 5632, NGU = 2 * DFF, NMOD = 6 * DM;
constexpr int NCMP = 127, NSLC = 32, NSEL = 8, WIN = 512;
constexpr int C_FQ = 0, C_FK = 1024, C_FV = 2048, C_NQ = 3072, C_NK = 4096, C_NV = 4864, C_FF = 5632, C_NG = 5640;
constexpr float SCALE = 0.08838834764831845f, EPS = 1e-6f, LOG2E = 1.4426950408889634f;

constexpr size_t MiB = 1u << 20;
constexpr size_t WS_CTL = 0, CTL_BYTES = 1 * MiB;
constexpr size_t WS_MODP = 1 * MiB;
constexpr size_t WS_MOD = 2 * MiB;
constexpr size_t WS_CUM = 2 * MiB + 256 * 1024;
constexpr size_t WS_KC = 2 * MiB + 512 * 1024;
constexpr size_t WS_VC = 2 * MiB + 768 * 1024;
constexpr size_t WS_TBL = 3 * MiB;
constexpr size_t WS_B1 = 3 * MiB + 16 * 1024;
constexpr size_t WS_W2T = 3 * MiB + 64 * 1024;
constexpr size_t WS_W1T = 4 * MiB;
constexpr size_t WS_SEL = 6 * MiB;
constexpr size_t WS_WIN = 8 * MiB;
constexpr size_t WS_WOUT = 31 * MiB;
constexpr size_t WS_WGU = 39 * MiB;
constexpr size_t WS_WDN = 83 * MiB;
constexpr size_t WS_H = 105 * MiB;
constexpr size_t WS_PROJ = 137 * MiB;
constexpr size_t WS_OF = 229 * MiB, WS_OC = 245 * MiB, WS_OS = 261 * MiB, WS_OW = 277 * MiB;
constexpr size_t WS_SCR = 293 * MiB;
constexpr size_t WS_END = 325 * MiB;

struct Args {
    const float* in[21];
    float* out;
    unsigned char* ws;
    int ph_lo, ph_hi, li, pad;
};
enum { I_X = 0, I_C, I_ADAW, I_ADAB, I_G1, I_G2, I_WIN, I_FB, I_FQG, I_FKG, I_NQG, I_NKG, I_POS, I_W1, I_W2, I_RB, I_MOG, I_WOUT, I_WG, I_WU, I_WD };

__device__ __forceinline__ float wave_sum(float v) {
#pragma unroll
    for (int o = 1; o < 64; o <<= 1) v += __shfl_xor(v, o);
    return v;
}
__device__ __forceinline__ float silu_f(float x) { return x / (1.f + __expf(-x)); }
__device__ __forceinline__ float sigmoid_f(float x) { return 1.f / (1.f + __expf(-x)); }
__device__ __forceinline__ int t5_bucket(int d) {
    if (d < 16) return d < 0 ? 0 : d;
    const int thr[15] = {19, 21, 24, 27, 31, 35, 40, 46, 52, 59, 67, 77, 87, 99, 113};
    int b = 16;
#pragma unroll
    for (int i = 0; i < 15; ++i) b += (d >= thr[i]) ? 1 : 0;
    return b;
}
__device__ __forceinline__ int win_src_col(int n) {
    if (n < 3072) return n;
    if (n < 4096) return 3080 + (n - 3072);
    if (n < 4864) return 4104 + (n - 4096);
    if (n < 5632) return 4872 + (n - 4864);
    if (n < 5640) return 3072 + (n - 5632);
    if (n < 5664) return n;
    return -1;
}
constexpr int NT = 512, NWV = 8;

__device__ __forceinline__ void transpose_item(const float* W, const float* W2, int Nsrc, int K, f16* WT, int mode, LAS float* scr, int kb, int nb, int lane) {
    const int k0 = 64 * kb, n0 = 32 * nb;
    const int nl = n0 + (lane & 31);
    int sc; const float* src = W;
    if (mode == 0) sc = win_src_col(nl);
    else if (mode == 1) sc = nl;
    else { const int p = nl >> 8, r = nl & 255; sc = 128 * p + (r & 127); src = (r < 128) ? W : W2; }
#pragma unroll 8
    for (int i = 0; i < 32; ++i) { const int kk = 2 * i + (lane >> 5); scr[kk * 33 + (lane & 31)] = (sc >= 0) ? src[(size_t)(k0 + kk) * Nsrc + sc] : 0.f; }
    asm volatile("s_waitcnt lgkmcnt(0)" ::: "memory");
    const int c = lane & 7;
#pragma unroll
    for (int j = 0; j < 4; ++j) { const int n = (lane >> 3) + 8 * j; const LAS float* s = scr + (8 * c) * 33 + n;
        h8 o;
#pragma unroll
        for (int i = 0; i < 8; ++i) o[i] = (f16)s[i * 33];
        *(h8*)(WT + (size_t)(n0 + n) * K + k0 + 8 * c) = o; }
    asm volatile("s_waitcnt lgkmcnt(0)" ::: "memory");
}

__device__ __forceinline__ void stage_prep(const Args& a, int bid, int nblk, LAS char* lds) {
    const int tid = threadIdx.x, lane = tid & 63, wave = __builtin_amdgcn_readfirstlane(tid >> 6);
    unsigned char* ws = a.ws;
    {
        LAS float* scr = (LAS float*)(lds + wave * 8448);
        f16* WIN_T = (f16*)(ws + WS_WIN); f16* WOUT_T = (f16*)(ws + WS_WOUT); f16* WGU_T = (f16*)(ws + WS_WGU); f16* WDN_T = (f16*)(ws + WS_WDN);
        f16* W1T = (f16*)(ws + WS_W1T); f16* W2T = (f16*)(ws + WS_W2T);
        constexpr int I_IN = 32 * (NP / 32), I_OUT = 32 * (DM / 32), I_GU = 32 * (NGU / 32), I_DN = (DFF / 64) * (DM / 32), I_1 = 2 * 64 * 4, I_2 = 2 * 2 * 4;
        constexpr int NIT = I_IN + I_OUT + I_GU + I_DN + I_1 + I_2;
        const int gw = bid * NWV + wave, ngw = nblk * NWV;
        for (int it = gw; it < NIT; it += ngw) {
            int r = it;
            if (r < I_IN) { transpose_item(a.in[I_WIN], nullptr, INW, DM, WIN_T, 0, scr, r / (NP / 32), r % (NP / 32), lane); continue; } r -= I_IN;
            if (r < I_OUT) { transpose_item(a.in[I_WOUT], nullptr, DM, DM, WOUT_T, 1, scr, r / (DM / 32), r % (DM / 32), lane); continue; } r -= I_OUT;
            if (r < I_GU) { transpose_item(a.in[I_WG], a.in[I_WU], DFF, DM, WGU_T, 2, scr, r / (NGU / 32), r % (NGU / 32), lane); continue; } r -= I_GU;
            if (r < I_DN) { transpose_item(a.in[I_WD], nullptr, DM, DFF, WDN_T, 1, scr, r / (DM / 32), r % (DM / 32), lane); continue; } r -= I_DN;
            if (r < I_1) { const int wh = r / 256, q = r % 256; transpose_item(a.in[I_W1] + (size_t)wh * 4096 * 128, nullptr, 128, 4096, W1T + (size_t)wh * 128 * 4096, 1, scr, q / 4, q % 4, lane); continue; } r -= I_1;
            { const int wh = r / 8, q = r % 8; transpose_item(a.in[I_W2] + (size_t)wh * 128 * 128, nullptr, 128, 128, W2T + (size_t)wh * 128 * 128, 1, scr, q / 4, q % 4, lane); }
        }
    }
    __syncthreads();
    {
        LAS float* sc = (LAS float*)lds;
        LAS float* red = (LAS float*)(lds + 8192);
        float* MODP = (float*)(ws + WS_MODP);
        const float* cin = a.in[I_C]; const float* W = a.in[I_ADAW];
        const int tx = tid & 15, ty = tid >> 4;
        for (int it = bid; it < 192 * 4; it += nblk) {
            const int cc = it % 192, kc = it / 192, col0 = cc * 64, kbase = kc * 512;
            for (int i = tid; i < 4 * 512; i += NT) { const int b = i >> 9, k = i & 511; sc[i] = silu_f(cin[b * DM + kbase + k]); }
            __syncthreads();
            f32x4 acc[4] = {};
#pragma unroll 4
            for (int p = 0; p < 16; ++p) { const int kl = p * 32 + ty; const f32x4 w = *(const f32x4*)(W + (size_t)(kbase + kl) * NMOD + col0 + tx * 4);
#pragma unroll
                for (int b = 0; b < 4; ++b) acc[b] += w * sc[b * 512 + kl]; }
#pragma unroll
            for (int b = 0; b < 4; ++b) *(LAS f32x4*)(red + (ty * 4 + b) * 64 + tx * 4) = acc[b];
            __syncthreads();
            if (tid < 256) { const int b = tid >> 6, c = tid & 63; float s = 0.f;
#pragma unroll 8
                for (int y = 0; y < 32; ++y) s += red[(y * 4 + b) * 64 + c];
                MODP[((size_t)kc * 4 + b) * NMOD + col0 + c] = s; }
            __syncthreads();
        }
    }
    if (bid == 0) {
        float* TBL = (float*)(ws + WS_TBL); const float* rb = a.in[I_RB];
        for (int i = tid; i < 8 * 128; i += NT) { const int h = i >> 7, d = i & 127; const float v = rb[t5_bucket(d) * 8 + h]; TBL[i] = v; TBL[1024 + i] = v - rb[31 * 8 + h]; }
    }
    for (int wh = bid; wh < 2; wh += nblk) {
        LAS float* red = (LAS float*)lds;
        const float* pos = a.in[I_POS] + wh * 4096; const float* w1 = a.in[I_W1] + (size_t)wh * 4096 * 128;
        const int n = tid & 127, q = tid >> 7; float s = 0.f;
        for (int k = q; k < 4096; k += 4) s += pos[k] * w1[(size_t)k * 128 + n];
        red[q * 128 + n] = s; __syncthreads();
        if (tid < 128) ((float*)(ws + WS_B1))[wh * 128 + tid] = red[tid] + red[128 + tid] + red[256 + tid] + red[384 + tid];
        __syncthreads();
    }
}

__device__ __forceinline__ void stage_norm(const Args& a, int bid, int nblk, LAS char* lds, int which) {
    const int tid = threadIdx.x, lane = tid & 63, wave = __builtin_amdgcn_readfirstlane(tid >> 6);
    unsigned char* ws = a.ws;
    const float* MODP = (const float*)(ws + WS_MODP); float* MOD = (float*)(ws + WS_MOD);
    const float* ada_b = a.in[I_ADAB];
    if (which == 0) {
        for (int i = bid * NT + tid; i < 4 * NMOD; i += nblk * NT) { const int n = i % NMOD;
            MOD[i] = MODP[i] + MODP[4 * NMOD + i] + MODP[8 * NMOD + i] + MODP[12 * NMOD + i] + ada_b[n]; }
    }
    const float* X = which == 0 ? a.in[I_X] : a.out; const float* gain = a.in[which == 0 ? I_G1 : I_G2];
    f16* H = (f16*)(ws + WS_H);
    LAS float* A_ = (LAS float*)lds; LAS float* B_ = (LAS float*)(lds + 8192);
    const int sh_off = which == 0 ? 0 : 3 * DM, sc_off = sh_off + DM;
    int cur_b = -1;
    for (int rb = bid; rb < NTOK / 32; rb += nblk) {
        const int b = rb / (SEQ / 32);
        if (b != cur_b) { __syncthreads();
            for (int k = tid; k < DM; k += NT) { float sc, sh;
                if (which == 0) { sc = ada_b[sc_off + k]; sh = ada_b[sh_off + k];
#pragma unroll
                    for (int kc = 0; kc < 4; ++kc) { sc += MODP[((size_t)kc * 4 + b) * NMOD + sc_off + k]; sh += MODP[((size_t)kc * 4 + b) * NMOD + sh_off + k]; } }
                else { sc = MOD[b * NMOD + sc_off + k]; sh = MOD[b * NMOD + sh_off + k]; }
                A_[k] = gain[k] * (1.f + sc); B_[k] = sh; }
            __syncthreads(); cur_b = b; }
#pragma unroll 1
        for (int rr = 0; rr < 4; ++rr) {
            const int m = rb * 32 + wave * 4 + rr;
            const f32x4* xr = (const f32x4*)(X + (size_t)m * DM);
            f32x4 v[8]; float ss = 0.f;
#pragma unroll
            for (int j = 0; j < 8; ++j) { v[j] = xr[j * 64 + lane]; ss += v[j].x * v[j].x + v[j].y * v[j].y + v[j].z * v[j].z + v[j].w * v[j].w; }
            const float r = rsqrtf(wave_sum(ss) * (1.f / DM) + EPS);
#pragma unroll
            for (int j = 0; j < 8; ++j) { const int k = j * 256 + lane * 4; const f32x4 aa = *(LAS f32x4*)(A_ + k), bb = *(LAS f32x4*)(B_ + k);
                h4 o; o.x = (f16)(v[j].x * r * aa.x + bb.x); o.y = (f16)(v[j].y * r * aa.y + bb.y); o.z = (f16)(v[j].z * r * aa.z + bb.z); o.w = (f16)(v[j].w * r * aa.w + bb.w);
                *(h4*)(H + (size_t)m * DM + k) = o; }
        }
    }
}

__device__ __forceinline__ void post_norms(const Args& a, int bid, int nblk) {
    const int tid = threadIdx.x, lane = tid & 63, wave = __builtin_amdgcn_readfirstlane(tid >> 6);
    f16* PROJ = (f16*)(a.ws + WS_PROJ);
    const int g = lane >> 4, l16 = lane & 15;
    for (int m = bid * NWV + wave; m < NTOK; m += nblk * NWV) {
        f16* row = PROJ + (size_t)m * NP;
#pragma unroll 1
        for (int it = 0; it < 7; ++it) {
            const int v = it * 4 + g; int col; const float* gn;
            if (v < 8) { col = C_FQ + v * 128; gn = a.in[I_FQG]; }
            else if (v < 16) { col = C_FK + (v - 8) * 128; gn = a.in[I_FKG]; }
            else if (v < 24) { col = C_NQ + (v - 16) * 128; gn = a.in[I_NQG]; }
            else { const int br = 1 + ((v - 24) >> 1), kvh = (v - 24) & 1; col = C_NK + br * 256 + kvh * 128; gn = a.in[I_NKG] + br * 128; }
            h8 x = *(h8*)(row + col + l16 * 8); float f[8]; float ss = 0.f;
#pragma unroll
            for (int i = 0; i < 8; ++i) { f[i] = (float)x[i]; ss += f[i] * f[i]; }
            ss += __shfl_xor(ss, 1); ss += __shfl_xor(ss, 2); ss += __shfl_xor(ss, 4); ss += __shfl_xor(ss, 8);
            const float r = rsqrtf(ss * (1.f / 128.f) + EPS);
#pragma unroll
            for (int i = 0; i < 8; ++i) x[i] = (f16)(f[i] * r * gn[l16 * 8 + i]);
            *(h8*)(row + col + l16 * 8) = x;
        }
    }
}
__device__ __forceinline__ void post_cumsum(const Args& a, int bid, int nblk) {
    const int tid = threadIdx.x, lane = tid & 63, wave = __builtin_amdgcn_readfirstlane(tid >> 6);
    const f16* PROJ = (const f16*)(a.ws + WS_PROJ); float* CUM = (float*)(a.ws + WS_CUM);
    for (int s = bid * NWV + wave; s < NB * NFH; s += nblk * NWV) {
        const int b = s >> 3, h = s & 7; const float fb = a.in[I_FB][h];
        float v[32]; float run = 0.f;
#pragma unroll
        for (int i = 0; i < 32; ++i) { const int t = lane * 32 + i; const float x = (float)PROJ[(size_t)(b * SEQ + t) * NP + C_FF + h] + fb;
            const float ls = fminf(x, 0.f) - log1pf(__expf(-fabsf(x))); run += ls; v[i] = run; }
        float incl = run;
#pragma unroll
        for (int o = 1; o < 64; o <<= 1) { const float n = __shfl_up(incl, o); if (lane >= o) incl += n; }
        const float excl = incl - run;
#pragma unroll
        for (int i = 0; i < 32; ++i) CUM[(size_t)s * SEQ + lane * 32 + i] = v[i] + excl;
    }
}

__device__ __forceinline__ void stage_ynorm(const Args& a, int bid, int nblk) {
    const int tid = threadIdx.x, lane = tid & 63, wave = __builtin_amdgcn_readfirstlane(tid >> 6);
    unsigned char* ws = a.ws;
    const f16* OF = (const f16*)(ws + WS_OF); const f16* OC = (const f16*)(ws + WS_OC); const f16* OS = (const f16*)(ws + WS_OS); const f16* OW = (const f16*)(ws + WS_OW);
    const f16* PROJ = (const f16*)(ws + WS_PROJ); f16* Y = (f16*)(ws + WS_H); const float* mog = a.in[I_MOG];
    for (int m = bid * NWV + wave; m < NTOK; m += nblk * NWV) {
        float f[16], n[16]; float ssf = 0.f, ssn = 0.f;
        const size_t o16 = (size_t)m * 1024 + lane * 16;
        const int hd = lane >> 3;
        const f16* gp = PROJ + (size_t)m * NP + C_NG + hd * 3;
        const float g0 = sigmoid_f((float)gp[0]), g1 = sigmoid_f((float)gp[1]), g2 = sigmoid_f((float)gp[2]);
#pragma unroll
        for (int hh = 0; hh < 2; ++hh) {
            const h8 xf = *(const h8*)(OF + o16 + hh * 8), xc = *(const h8*)(OC + o16 + hh * 8), xs = *(const h8*)(OS + o16 + hh * 8), xw = *(const h8*)(OW + o16 + hh * 8);
#pragma unroll
            for (int i = 0; i < 8; ++i) { f[hh * 8 + i] = (float)xf[i]; n[hh * 8 + i] = g0 * (float)xc[i] + g1 * (float)xs[i] + g2 * (float)xw[i];
                ssf += f[hh * 8 + i] * f[hh * 8 + i]; ssn += n[hh * 8 + i] * n[hh * 8 + i]; }
        }
        const float rf = rsqrtf(wave_sum(ssf) * (1.f / 1024.f) + EPS), rn = rsqrtf(wave_sum(ssn) * (1.f / 1024.f) + EPS);
#pragma unroll
        for (int hh = 0; hh < 2; ++hh) { h8 of, on;
#pragma unroll
            for (int i = 0; i < 8; ++i) { const int k = lane * 16 + hh * 8 + i; of[i] = (f16)(f[hh * 8 + i] * rf * mog[k]); on[i] = (f16)(n[hh * 8 + i] * rn * mog[1024 + k]); }
            *(h8*)(Y + (size_t)m * DM + lane * 16 + hh * 8) = of; *(h8*)(Y + (size_t)m * DM + 1024 + lane * 16 + hh * 8) = on; }
    }
}
#if NAIVE_BUILD
template <int MODE> __global__ void __launch_bounds__(256) naive_gemm(Args a) {
    unsigned char* ws = a.ws;
    const int tx = threadIdx.x & 15, ty = threadIdx.x >> 4;
    const int n0 = blockIdx.x * 64 + tx * 4, m0 = blockIdx.y * 64 + ty * 4;
    const f16* A; const f16* Bt; int K;
    if (MODE == 0) { A = (const f16*)(ws + WS_H); Bt = (const f16*)(ws + WS_WIN); K = DM; }
    else if (MODE == 1) { A = (const f16*)(ws + WS_H); Bt = (const f16*)(ws + WS_WOUT); K = DM; }
    else if (MODE == 2) { A = (const f16*)(ws + WS_H); Bt = (const f16*)(ws + WS_WGU); K = DM; }
    else { A = (const f16*)(ws + WS_PROJ); Bt = (const f16*)(ws + WS_WDN); K = DFF; }
    int brow[4], urow[4];
#pragma unroll
    for (int j = 0; j < 4; ++j) { const int n = n0 + j;
        if (MODE == 2) { brow[j] = 256 * (n >> 7) + (n & 127); urow[j] = brow[j] + 128; } else { brow[j] = n; urow[j] = n; } }
    float acc[4][4] = {}, accu[4][4] = {};
    for (int k = 0; k < K; k += 8) {
        h8 av[4], bv[4], uv[4];
#pragma unroll
        for (int i = 0; i < 4; ++i) av[i] = *(const h8*)(A + (size_t)(m0 + i) * K + k);
#pragma unroll
        for (int j = 0; j < 4; ++j) { bv[j] = *(const h8*)(Bt + (size_t)brow[j] * K + k); if (MODE == 2) uv[j] = *(const h8*)(Bt + (size_t)urow[j] * K + k); }
#pragma unroll
        for (int e = 0; e < 8; ++e)
#pragma unroll
            for (int i = 0; i < 4; ++i)
#pragma unroll
                for (int j = 0; j < 4; ++j) { acc[i][j] += (float)av[i][e] * (float)bv[j][e]; if (MODE == 2) accu[i][j] += (float)av[i][e] * (float)uv[j][e]; }
    }
    const float* MOD = (const float*)(ws + WS_MOD);
#pragma unroll
    for (int i = 0; i < 4; ++i) { const int m = m0 + i, b = m / SEQ;
#pragma unroll
        for (int j = 0; j < 4; ++j) { const int n = n0 + j;
            if (MODE == 0) ((f16*)(ws + WS_PROJ))[(size_t)m * NP + n] = (f16)acc[i][j];
            else if (MODE == 1) a.out[(size_t)m * DM + n] = a.in[I_X][(size_t)m * DM + n] + MOD[b * NMOD + 2 * DM + n] * acc[i][j];
            else if (MODE == 2) ((f16*)(ws + WS_PROJ))[(size_t)m * DFF + n] = (f16)(silu_f(acc[i][j]) * accu[i][j]);
            else a.out[(size_t)m * DM + n] = a.out[(size_t)m * DM + n] + MOD[b * NMOD + 5 * DM + n] * acc[i][j]; } }
}

__device__ __forceinline__ void row_step(bool valid, float bias, const h8 (&q)[16], const f16* krow, const f16* vrow, float& m, float& l, float (&o)[128]) {
    float s = 0.f;
#pragma unroll
    for (int c = 0; c < 16; ++c) { const h8 kv = *(const h8*)(krow + c * 8);
#pragma unroll
        for (int e = 0; e < 8; ++e) s += (float)q[c][e] * (float)kv[e]; }
    s = s * SCALE + bias;
    if (valid) {
        const float mn = fmaxf(m, s), al = __expf(m - mn), p = __expf(s - mn);
        l = l * al + p; m = mn;
#pragma unroll
        for (int c = 0; c < 16; ++c) { const h8 vv = *(const h8*)(vrow + c * 8);
#pragma unroll
            for (int e = 0; e < 8; ++e) o[c * 8 + e] = o[c * 8 + e] * al + p * (float)vv[e]; }
    }
}
__device__ __forceinline__ void row_store(f16* dst, float l, const float (&o)[128]) {
    const float inv = l > 0.f ? 1.f / l : 0.f;
#pragma unroll
    for (int c = 0; c < 16; ++c) { h8 w;
#pragma unroll
        for (int e = 0; e < 8; ++e) w[e] = (f16)(o[c * 8 + e] * inv);
        *(h8*)(dst + c * 8) = w; }
}

__global__ void __launch_bounds__(256) naive_fox(Args a) {
    unsigned char* ws = a.ws; const f16* PROJ = (const f16*)(ws + WS_PROJ); const float* CUM = (const float*)(ws + WS_CUM);
    const int tb = blockIdx.x & 7, h = (blockIdx.x >> 3) & 7, b = blockIdx.x >> 6, t = tb * 256 + threadIdx.x;
    h8 q[16];
#pragma unroll
    for (int c = 0; c < 16; ++c) q[c] = *(const h8*)(PROJ + (size_t)(b * SEQ + t) * NP + C_FQ + h * 128 + c * 8);
    const float* cum = CUM + (size_t)(b * 8 + h) * SEQ; const float cq = cum[t];
    float m = -1e30f, l = 0.f; float o[128];
#pragma unroll
    for (int i = 0; i < 128; ++i) o[i] = 0.f;
    const int jmax = tb * 256 + 255;
    for (int j = 0; j <= jmax; ++j) {
        const f16* kr = PROJ + (size_t)(b * SEQ + j) * NP + C_FK + h * 128; const f16* vr = PROJ + (size_t)(b * SEQ + j) * NP + C_FV + h * 128;
        row_step(j <= t, cq - cum[j], q, kr, vr, m, l, o);
    }
    row_store((f16*)(ws + WS_OF) + (size_t)(b * SEQ + t) * 1024 + h * 128, l, o);
}
__global__ void __launch_bounds__(256) naive_cmp(Args a) {
    unsigned char* ws = a.ws; const f16* PROJ = (const f16*)(ws + WS_PROJ); const float* TBL = (const float*)(ws + WS_TBL);
    const int tb = blockIdx.x & 7, h = (blockIdx.x >> 3) & 7, b = blockIdx.x >> 6, t = tb * 256 + threadIdx.x, kvh = h >> 2;
    const f16* KC = (const f16*)(ws + WS_KC) + (size_t)(b * 2 + kvh) * 128 * 128; const f16* VC = (const f16*)(ws + WS_VC) + (size_t)(b * 2 + kvh) * 128 * 128;
    float* PC = (float*)(ws + WS_SCR) + ((size_t)(b * SEQ + t) * 8 + h) * 128;
    h8 q[16];
#pragma unroll
    for (int c = 0; c < 16; ++c) q[c] = *(const h8*)(PROJ + (size_t)(b * SEQ + t) * NP + C_NQ + h * 128 + c * 8);
    float m = -1e30f, l = 0.f; float o[128];
#pragma unroll
    for (int i = 0; i < 128; ++i) o[i] = 0.f;
    for (int c = 0; c < NCMP; ++c) { const int d = t - (16 * c + 31); const int dd = d < 0 ? 0 : (d > 127 ? 127 : d);
        row_step(d >= 0, TBL[h * 128 + dd], q, KC + c * 128, VC + c * 128, m, l, o); }
    row_store((f16*)(ws + WS_OC) + (size_t)(b * SEQ + t) * 1024 + h * 128, l, o);
    const float inv = l > 0.f ? 1.f / l : 0.f;
    for (int c = 0; c < 128; ++c) { const int d = t - (16 * c + 31); float p = 0.f;
        if (c < NCMP && d >= 0) { const int dd = d > 127 ? 127 : d; float s = 0.f;
#pragma unroll
            for (int cc = 0; cc < 16; ++cc) { const h8 kv = *(const h8*)(KC + c * 128 + cc * 8);
#pragma unroll
                for (int e = 0; e < 8; ++e) s += (float)q[cc][e] * (float)kv[e]; }
            p = __expf(s * SCALE + TBL[h * 128 + dd] - m) * inv; }
        PC[c] = p; }
}
__device__ __forceinline__ unsigned topk_mask(const float (&impin)[32], int t) {
    float v[32]; const int cur = t >> 6;
#pragma unroll
    for (int j = 0; j < 32; ++j) { float x = impin[j]; if (j == 0 || j == cur || j == cur - 1) x = 1e6f; if (j > cur) x = -__builtin_inff(); v[j] = x; }
    unsigned mask = 0u;
#pragma unroll 1
    for (int it = 0; it < NSEL; ++it) { float best = -__builtin_inff(); int bi = -1;
#pragma unroll
        for (int j = 0; j < 32; ++j) if (v[j] > best) { best = v[j]; bi = j; }
        if (bi < 0) break;
        mask |= 1u << bi;
#pragma unroll
        for (int j = 0; j < 32; ++j) if (j == bi) v[j] = -__builtin_inff(); }
    return mask;
}
__global__ void __launch_bounds__(256) naive_topk(Args a) {
    unsigned char* ws = a.ws;
    const int idx = blockIdx.x * 256 + threadIdx.x; if (idx >= NTOK * 2) return;
    const int tok = idx >> 1, kvh = idx & 1, t = tok & (SEQ - 1);
    const float* PC = (const float*)(ws + WS_SCR) + ((size_t)tok * 8 + kvh * 4) * 128;
    float imp[32];
#pragma unroll
    for (int j = 0; j < 32; ++j) { float s = 0.f;
#pragma unroll
        for (int hh = 0; hh < 4; ++hh) { const float* p = PC + hh * 128;
            if (j > 0) s += p[4 * j - 1];
            s += 2.f * (p[4 * j] + p[4 * j + 1] + p[4 * j + 2]); if (4 * j + 3 < NCMP) s += p[4 * j + 3]; }
        imp[j] = s; }
    ((unsigned*)(ws + WS_SEL))[idx] = topk_mask(imp, t);
}
__global__ void __launch_bounds__(256) naive_selwin(Args a) {
    unsigned char* ws = a.ws; const f16* PROJ = (const f16*)(ws + WS_PROJ); const float* TBL = (const float*)(ws + WS_TBL);
    const int tb = blockIdx.x & 7, h = (blockIdx.x >> 3) & 7, b = blockIdx.x >> 6, t = tb * 256 + threadIdx.x, kvh = h >> 2;
    h8 q[16];
#pragma unroll
    for (int c = 0; c < 16; ++c) q[c] = *(const h8*)(PROJ + (size_t)(b * SEQ + t) * NP + C_NQ + h * 128 + c * 8);
    const unsigned mask = ((const unsigned*)(ws + WS_SEL))[(size_t)(b * SEQ + t) * 2 + kvh];
    float o[128];
    {
        float m = -1e30f, l = 0.f;
#pragma unroll
        for (int i = 0; i < 128; ++i) o[i] = 0.f;
        const int jmax = (tb * 256 + 255) >> 6;
        for (int j = 0; j <= jmax; ++j) { const bool sel = (mask >> j) & 1u;
            if (!__any(sel)) continue;
            for (int i = 0; i < 64; ++i) { const int s = j * 64 + i; const int d = t - s; const int dd = d < 0 ? 0 : (d > 127 ? 127 : d);
                const f16* kr = PROJ + (size_t)(b * SEQ + s) * NP + C_NK + 256 + kvh * 128; const f16* vr = PROJ + (size_t)(b * SEQ + s) * NP + C_NV + 256 + kvh * 128;
                row_step(sel && d >= 0, TBL[h * 128 + dd], q, kr, vr, m, l, o); } }
        row_store((f16*)(ws + WS_OS) + (size_t)(b * SEQ + t) * 1024 + h * 128, l, o);
    }
    {
        float m = -1e30f, l = 0.f;
#pragma unroll
        for (int i = 0; i < 128; ++i) o[i] = 0.f;
        int s0 = tb * 256 - (WIN - 1); if (s0 < 0) s0 = 0; const int s1 = tb * 256 + 255;
        for (int s = s0; s <= s1; ++s) { const int d = t - s; const int dd = d < 0 ? 0 : (d > 127 ? 127 : d);
            const f16* kr = PROJ + (size_t)(b * SEQ + s) * NP + C_NK + 512 + kvh * 128; const f16* vr = PROJ + (size_t)(b * SEQ + s) * NP + C_NV + 512 + kvh * 128;
            row_step(d >= 0 && d < WIN, TBL[h * 128 + dd], q, kr, vr, m, l, o); }
        row_store((f16*)(ws + WS_OW) + (size_t)(b * SEQ + t) * 1024 + h * 128, l, o);
    }
}
__global__ void __launch_bounds__(128) naive_compress(Args a) {
    unsigned char* ws = a.ws; const f16* PROJ = (const f16*)(ws + WS_PROJ);
    __shared__ float hid[128]; __shared__ float red[2];
    const int c = blockIdx.x & 127, kvh = (blockIdx.x >> 7) & 1, b = (blockIdx.x >> 8) & 3, wh = blockIdx.x >> 10, n = threadIdx.x;
    f16* dst = (f16*)(ws + (wh == 0 ? WS_KC : WS_VC)) + ((size_t)(b * 2 + kvh) * 128 + c) * 128;
    if (c >= NCMP) { dst[n] = (f16)0.f; return; }
    const float* w1 = a.in[I_W1] + (size_t)wh * 4096 * 128; const float* w2 = a.in[I_W2] + (size_t)wh * 128 * 128; const float* pos = a.in[I_POS] + wh * 4096;
    const int col = (wh == 0 ? C_NK : C_NV) + kvh * 128;
    float s = 0.f;
    for (int l = 0; l < 32; ++l) { const f16* xr = PROJ + (size_t)(b * SEQ + 16 * c + l) * NP + col;
        for (int d = 0; d < 128; ++d) s += ((float)xr[d] + pos[l * 128 + d]) * w1[(size_t)(l * 128 + d) * 128 + n]; }
    hid[n] = silu_f(s); __syncthreads();
    float o = 0.f;
    for (int k = 0; k < 128; ++k) o += hid[k] * w2[k * 128 + n];
    if (wh == 0) { float ss = wave_sum(o * o); if ((n & 63) == 0) red[n >> 6] = ss; __syncthreads(); ss = red[0] + red[1];
        o = o * rsqrtf(ss * (1.f / 128.f) + EPS) * a.in[I_NKG][n]; }
    dst[n] = (f16)o;
}
#endif
namespace pg8 {
#define PG8_LAS __attribute__((address_space(3)))
typedef _Float16 bf16_t;
typedef _Float16 bf16x8 __attribute__((ext_vector_type(8)));
typedef float f32x4 __attribute__((ext_vector_type(4)));
typedef unsigned u32x4 __attribute__((ext_vector_type(4)));
constexpr int BM = 256, BK = 64, HALF = 128, HTB = HALF * BK * 2  , STAGE_BYTES = 8 * HTB, NXCD = 8, WGM = 8;

__host__ __device__ __forceinline__ int lds_byte(int r, int c) { const int st = (r >> 4) * 2 + (c >> 5), rr = r & 15, cc = c & 31, ob = rr * 64 + cc * 2; return st * 1024 + (ob ^ (((ob >> 9) & 1) << 5)); }
__host__ __device__ __forceinline__ void stage_rc(int b, int& R, int& C) { const int st = b / 1024, sb = b % 1024, swz = sb ^ (((sb >> 9) & 1) << 5); R = (st >> 1) * 16 + swz / 64; C = (st & 1) * 32 + (swz % 64) / 2; }
__host__ __device__ __forceinline__ int perm32(int rho) { const int n = rho >> 4, i = rho & 15; return 8 * (i >> 2) + 4 * n + (i & 3); }

struct Unit { int pm, pn; };
struct Gemm { const bf16_t* A; const bf16_t* Bt; int M, N, K; };

struct StaticOrder {
    int nM, nN, nwg, G, c;
    __host__ __device__ void init(int M, int N, int G_, int c_) { nM = M / BM; nN = N / BM; nwg = nM * nN; G = G_; c = c_; }
    __host__ __device__ bool next(int i, Unit& u) const {
        const long L = (long)i * G + c; if (L >= nwg) return false;
        int wgid = (int)L; { const int q = nwg / NXCD, r = nwg % NXCD, xcd = wgid % NXCD, off = wgid / NXCD; wgid = (xcd < r ? xcd * (q + 1) : r * (q + 1) + (xcd - r) * q) + off; }
        const int nig = WGM * nN, gid = wgid / nig, fm = gid * WGM, gsz = (nM - fm) < WGM ? (nM - fm) : WGM;
        u.pm = fm + ((wgid % nig) % gsz); u.pn = (wgid % nig) / gsz; return true;
    }
    __device__ __forceinline__ void a_ready(const Unit&) const {}
    __device__ __forceinline__ void done(const Unit&) const {}
};

template <class Epi, class Sched, bool ALIGN_EPI = false, bool SP2 = false>
__device__ __forceinline__ void gemm_phase(PG8_LAS unsigned char* lds, const Gemm g, const Sched& S, const Epi& E) {
    const int tid = threadIdx.x, wid = __builtin_amdgcn_readfirstlane(tid >> 6), lane = tid & 63, wr = wid >> 2, wc = wid & 3, fr = lane & 15, fq = lane >> 4;
    const int K = g.K, nt = K / BK;
    unsigned voffA[2], voffB[2];
#pragma unroll
    for (int i = 0; i < 2; ++i) { int R, C; stage_rc(tid * 16 + i * 8192, R, C); const int Rb = Epi::PERM ? ((R & ~31) + perm32(R & 31)) : R;
        voffA[i] = (unsigned)(R * K + C) * 2u; voffB[i] = (unsigned)(Rb * K + C) * 2u; }
    const size_t kstep = (size_t)(BK * 2);
    const size_t hstep = (size_t)HALF * K * 2;
    const size_t tstep = 2 * hstep;
    const unsigned ldsw = (unsigned)wid * 1024u;
    const int aoff = lds_byte(wr * 64 + fr, fq * 8), boff = lds_byte(wc * 32 + fr, fq * 8);
#define PG8_SA(b, h) (((b) * 2 + (h)) * HTB)
#define PG8_SB(b, h) ((4 + (b) * 2 + (h)) * HTB)
#define PG8_STAGE(bufoff, gbase, voff) do { _Pragma("unroll") for (int _i = 0; _i < 2; ++_i) \
        __builtin_amdgcn_global_load_lds((const unsigned*)((const char*)(gbase) + (voff)[_i]), (PG8_LAS unsigned*)(lds + (bufoff) + ldsw + _i * 8192), 16, 0, 0); } while (0)
#define PG8_LDA(dst, b, h) do { _Pragma("unroll") for (int m = 0; m < 4; ++m) _Pragma("unroll") for (int k = 0; k < 2; ++k) dst[m][k] = *(const PG8_LAS bf16x8*)(lds + PG8_SA(b, h) + aoff + m * 2048 + k * 1024); } while (0)
#define PG8_LDB(dst, b, h) do { _Pragma("unroll") for (int n = 0; n < 2; ++n) _Pragma("unroll") for (int k = 0; k < 2; ++k) dst[n][k] = *(const PG8_LAS bf16x8*)(lds + PG8_SB(b, h) + boff + n * 2048 + k * 1024); } while (0)
#define PG8_MMA(ai, bj, At, Bt) do { __builtin_amdgcn_s_setprio(1); _Pragma("unroll") for (int m = 0; m < 4; ++m) _Pragma("unroll") for (int n = 0; n < 2; ++n) _Pragma("unroll") for (int k = 0; k < 2; ++k) \
        acc[ai][bj][m][n] = __builtin_amdgcn_mfma_f32_16x16x32_f16(Bt[n][k], At[m][k], acc[ai][bj][m][n], 0, 0, 0); __builtin_amdgcn_s_setprio(0); } while (0)
#define PG8_WAIT_V(n) asm volatile("s_waitcnt vmcnt(" #n ")" ::: "memory")
#define PG8_WAIT_L(n) asm volatile("s_waitcnt lgkmcnt(" #n ")" ::: "memory")
#define PG8_BAR __builtin_amdgcn_s_barrier()
#define PG8_SCHED __builtin_amdgcn_sched_barrier(0)
    Unit cur, nxt; int ui = 0;
    if (!S.next(0, cur)) return;
    f32x4 acc[2][2][4][2];
#pragma unroll
    for (int a = 0; a < 2; ++a)
#pragma unroll
        for (int b = 0; b < 2; ++b)
#pragma unroll
            for (int m = 0; m < 4; ++m)
#pragma unroll
                for (int n = 0; n < 2; ++n) acc[a][b][m][n] = (f32x4){0.f, 0.f, 0.f, 0.f};
    bf16x8 At[4][2], B0[2][2], B1[2][2];
    const char* cA = (const char*)g.A + (size_t)cur.pm * tstep; const char* cB = (const char*)g.Bt + (size_t)cur.pn * tstep;
    S.a_ready(cur);
    if constexpr (SP2) {
        PG8_STAGE(PG8_SB(0, 0), cB, voffB); PG8_STAGE(PG8_SB(0, 1), cB + hstep, voffB); PG8_STAGE(PG8_SA(0, 0), cA, voffA); PG8_STAGE(PG8_SA(0, 1), cA + hstep, voffA);
        if (wr == 1) PG8_BAR;
        PG8_WAIT_V(2); PG8_BAR;
        PG8_STAGE(PG8_SB(1, 0), cB + kstep, voffB); PG8_STAGE(PG8_SA(1, 0), cA + kstep, voffA); PG8_STAGE(PG8_SB(1, 1), cB + hstep + kstep, voffB);
        PG8_WAIT_V(6); PG8_BAR;
    } else {
        PG8_STAGE(PG8_SB(0, 0), cB, voffB); PG8_STAGE(PG8_SA(0, 0), cA, voffA); PG8_STAGE(PG8_SB(0, 1), cB + hstep, voffB); PG8_STAGE(PG8_SA(0, 1), cA + hstep, voffA);
        if (wr == 1) PG8_BAR;
        PG8_WAIT_V(4); PG8_BAR;
        PG8_STAGE(PG8_SB(1, 0), cB + kstep, voffB); PG8_STAGE(PG8_SA(1, 0), cA + kstep, voffA); PG8_STAGE(PG8_SB(1, 1), cB + hstep + kstep, voffB);
        PG8_WAIT_V(6); PG8_BAR;
    }
    for (;;) {
        const bool has_next = S.next(ui + 1, nxt);
        const char* nA = has_next ? (const char*)g.A + (size_t)nxt.pm * tstep : cA; const char* nB = has_next ? (const char*)g.Bt + (size_t)nxt.pn * tstep : cB;
        for (int t = 0; t < nt; t += 2) {
            const bool last = (t == nt - 2);
            const char* a1 = cA + (size_t)(t + 1) * kstep;
            const char* a2 = last ? nA : cA + (size_t)(t + 2) * kstep; const char* b2 = last ? nB : cB + (size_t)(t + 2) * kstep;
            const char* a3 = a2 + kstep; const char* b3 = b2 + kstep;
            if (last && has_next) S.a_ready(nxt);
            if constexpr (SP2) {
            PG8_LDB(B0, 0, 0); PG8_LDB(B1, 0, 1); PG8_SCHED; PG8_LDA(At, 0, 0); PG8_STAGE(PG8_SA(1, 1), a1 + hstep, voffA);
            PG8_WAIT_V(8); PG8_WAIT_L(0); PG8_BAR; PG8_MMA(0, 0, At, B0); PG8_MMA(0, 1, At, B1); PG8_BAR; PG8_SCHED;
            PG8_LDA(At, 0, 1); PG8_STAGE(PG8_SB(0, 0), b2, voffB); PG8_STAGE(PG8_SB(0, 1), b2 + hstep, voffB); PG8_STAGE(PG8_SA(0, 0), a2, voffA);
            PG8_WAIT_V(8); PG8_WAIT_L(0); PG8_BAR; PG8_MMA(1, 0, At, B0); PG8_MMA(1, 1, At, B1); PG8_BAR; PG8_SCHED;
            PG8_LDB(B0, 1, 0); PG8_LDB(B1, 1, 1); PG8_SCHED; PG8_LDA(At, 1, 0); PG8_STAGE(PG8_SA(0, 1), a2 + hstep, voffA);
            PG8_WAIT_V(8); PG8_WAIT_L(0); PG8_BAR; PG8_MMA(0, 0, At, B0); PG8_MMA(0, 1, At, B1); PG8_BAR; PG8_SCHED;
            PG8_LDA(At, 1, 1); PG8_STAGE(PG8_SB(1, 0), b3, voffB); PG8_STAGE(PG8_SB(1, 1), b3 + hstep, voffB); PG8_STAGE(PG8_SA(1, 0), a3, voffA);
            PG8_WAIT_V(8); PG8_WAIT_L(0); PG8_BAR; PG8_MMA(1, 0, At, B0); PG8_MMA(1, 1, At, B1); PG8_BAR; PG8_SCHED;
            } else {
            PG8_LDB(B0, 0, 0); PG8_SCHED; PG8_LDA(At, 0, 0); PG8_STAGE(PG8_SA(1, 1), a1 + hstep, voffA);
            PG8_WAIT_L(8); PG8_BAR; PG8_WAIT_L(0); PG8_MMA(0, 0, At, B0); PG8_BAR; PG8_SCHED;
            PG8_LDB(B1, 0, 1); PG8_STAGE(PG8_SB(0, 0), b2, voffB);
            PG8_BAR; PG8_WAIT_L(0); PG8_MMA(0, 1, At, B1); PG8_BAR;
            PG8_LDA(At, 0, 1); PG8_STAGE(PG8_SA(0, 0), a2, voffA);
            PG8_BAR; PG8_WAIT_L(0); PG8_MMA(1, 0, At, B0); PG8_BAR; PG8_SCHED;
            PG8_STAGE(PG8_SB(0, 1), b2 + hstep, voffB);
            PG8_WAIT_V(6); PG8_BAR; PG8_MMA(1, 1, At, B1); PG8_BAR;
            PG8_LDB(B0, 1, 0); PG8_SCHED; PG8_LDA(At, 1, 0); PG8_STAGE(PG8_SA(0, 1), a2 + hstep, voffA);
            PG8_WAIT_L(8); PG8_BAR; PG8_WAIT_L(0); PG8_MMA(0, 0, At, B0); PG8_BAR; PG8_SCHED;
            PG8_LDB(B1, 1, 1); PG8_STAGE(PG8_SB(1, 0), b3, voffB);
            PG8_BAR; PG8_WAIT_L(0); PG8_MMA(0, 1, At, B1); PG8_BAR;
            PG8_LDA(At, 1, 1); PG8_STAGE(PG8_SA(1, 0), a3, voffA);
            PG8_BAR; PG8_WAIT_L(0); PG8_MMA(1, 0, At, B0); PG8_BAR; PG8_SCHED;
            PG8_STAGE(PG8_SB(1, 1), b3 + hstep, voffB);
            PG8_WAIT_V(6); PG8_BAR; PG8_MMA(1, 1, At, B1); PG8_BAR;
            }
        }
        if constexpr (ALIGN_EPI) { if (wr == 0) PG8_BAR; }
        if constexpr (!Epi::AFTER_DRAIN) { E(acc, cur, wr, wc, fr, fq); S.done(cur); }
        if (!has_next) break;
#pragma unroll
        for (int a = 0; a < 2; ++a)
#pragma unroll
            for (int b = 0; b < 2; ++b)
#pragma unroll
                for (int m = 0; m < 4; ++m)
#pragma unroll
                    for (int n = 0; n < 2; ++n) acc[a][b][m][n] = (f32x4){0.f, 0.f, 0.f, 0.f};
        cur = nxt; cA = nA; cB = nB; ++ui;
        if constexpr (ALIGN_EPI) { if (wr == 1) PG8_BAR; }
    }
    PG8_WAIT_V(0);
    if constexpr (!ALIGN_EPI) { if (wr == 0) PG8_BAR; }
    PG8_BAR;
    if constexpr (Epi::AFTER_DRAIN) { E.fused(acc, cur, wr, wc, fr, fq, lds, wid, lane); S.done(cur); }
#undef PG8_SA
#undef PG8_SB
#undef PG8_STAGE
#undef PG8_LDA
#undef PG8_LDB
#undef PG8_MMA
#undef PG8_WAIT_V
#undef PG8_WAIT_L
#undef PG8_BAR
#undef PG8_SCHED
}
}
namespace pg8 {
struct EpiProj {
    static constexpr bool PERM = true, AFTER_DRAIN = false;
    f16* O; int ldc;
    __device__ __forceinline__ void operator()(const f32x4 (&acc)[2][2][4][2], const Unit& u, int wr, int wc, int fr, int fq) const {
        const int row0 = u.pm * BM + wr * 64 + fr, col0 = u.pn * BM + wc * 32 + 8 * fq;
#pragma unroll
        for (int ai = 0; ai < 2; ++ai)
#pragma unroll
            for (int m = 0; m < 4; ++m) { f16* rowp = O + (size_t)(row0 + ai * HALF + m * 16) * ldc + col0;
#pragma unroll
                for (int bj = 0; bj < 2; ++bj) { const f32x4 v0 = acc[ai][bj][m][0], v1 = acc[ai][bj][m][1];
                    h8 w; w[0] = (f16)v0[0]; w[1] = (f16)v0[1]; w[2] = (f16)v0[2]; w[3] = (f16)v0[3]; w[4] = (f16)v1[0]; w[5] = (f16)v1[1]; w[6] = (f16)v1[2]; w[7] = (f16)v1[3];
                    *(h8*)(rowp + bj * HALF) = w; } }
    }
};
struct EpiGU {
    static constexpr bool PERM = true, AFTER_DRAIN = false;
    f16* O;
    __device__ __forceinline__ void operator()(const f32x4 (&acc)[2][2][4][2], const Unit& u, int wr, int wc, int fr, int fq) const {
        const int row0 = u.pm * BM + wr * 64 + fr, col0 = u.pn * HALF + wc * 32 + 8 * fq;
#pragma unroll
        for (int ai = 0; ai < 2; ++ai)
#pragma unroll
            for (int m = 0; m < 4; ++m) { h8 w;
#pragma unroll
                for (int n = 0; n < 2; ++n)
#pragma unroll
                    for (int e = 0; e < 4; ++e) { const float g = acc[ai][0][m][n][e], up = acc[ai][1][m][n][e];
                        w[n * 4 + e] = (f16)(g * __builtin_amdgcn_rcpf(1.f + __expf(-g)) * up); }
                *(h8*)(O + (size_t)(row0 + ai * HALF + m * 16) * DFF + col0) = w; }
    }
};
struct EpiRes {
    static constexpr bool PERM = false, AFTER_DRAIN = false;
    const float* base; float* out; const float* gate;
    __device__ __forceinline__ void operator()(const f32x4 (&acc)[2][2][4][2], const Unit& u, int wr, int wc, int fr, int fq) const {
        const int row0 = u.pm * BM + wr * 64 + fr, col0 = u.pn * BM + wc * 32 + 4 * fq;
        const float* gp = gate + (size_t)((u.pm * BM) / SEQ) * NMOD + col0;
        f32x4 gv[2][2];
#pragma unroll
        for (int bj = 0; bj < 2; ++bj)
#pragma unroll
            for (int n = 0; n < 2; ++n) gv[bj][n] = *(const f32x4*)(gp + bj * HALF + n * 16);
#pragma unroll
        for (int ai = 0; ai < 2; ++ai)
#pragma unroll
            for (int m = 0; m < 4; ++m) { const size_t off = (size_t)(row0 + ai * HALF + m * 16) * DM + col0;
#pragma unroll
                for (int bj = 0; bj < 2; ++bj)
#pragma unroll
                    for (int n = 0; n < 2; ++n) { const f32x4 bs = *(const f32x4*)(base + off + bj * HALF + n * 16);
                        *(f32x4*)(out + off + bj * HALF + n * 16) = bs + gv[bj][n] * acc[ai][bj][m][n]; } }
    }
};
}
#ifndef PG8_SP2
#define PG8_SP2 true
#endif
#ifndef PG8_ALIGN
#define PG8_ALIGN true
#endif
#define XB_TMO      128
#define XB_XCNT(j)  (256  + 64 * (j))
#define XB_XSUB(j)  (1280 + 64 * (j))
#define XB_XGEN(j)  (2304 + 64 * (j))
#define XB_TOP      3328
#define XB_TOPGEN   3392
#define XCD_BAR_WORDS 3456
#define XB_SPIN_CAP (1u << 18)

__device__ __forceinline__ unsigned xb_ld(unsigned* p)              { return __hip_atomic_load(p, __ATOMIC_RELAXED, __HIP_MEMORY_SCOPE_AGENT); }
__device__ __forceinline__ unsigned xb_add(unsigned* p, unsigned v) { return __hip_atomic_fetch_add(p, v, __ATOMIC_RELAXED, __HIP_MEMORY_SCOPE_AGENT); }
__device__ __forceinline__ unsigned xb_xcc_id() { return (unsigned)__builtin_amdgcn_s_getreg((3 << 11) | 20) & 0xFu; }
#define XB_SPIN(cond, bar) do { unsigned _sp = 0; while (cond) { __builtin_amdgcn_s_sleep(1); \
    if ((++_sp & 255u) == 0u) { if (xb_ld(&(bar)[XB_TMO])) break; if (_sp > XB_SPIN_CAP) { atomicAdd(&(bar)[XB_TMO], 1u); break; } } } } while (0)

struct XcdBarrier {
    unsigned* bar; unsigned x;
    volatile LAS unsigned* st;
};

__device__ __forceinline__ XcdBarrier xcd_barrier_post(unsigned* bar, volatile LAS unsigned* st) {
    XcdBarrier b; b.bar = bar; b.x = xb_xcc_id(); b.st = st;
    if (threadIdx.x == 0) (void)xb_add(&bar[XB_XCNT(b.x)], 1u);
    return b;
}
__device__ __forceinline__ void xcd_barrier_complete(unsigned* bar, unsigned x, unsigned& nloc, unsigned& nx) {
    const unsigned G = gridDim.x * gridDim.y * gridDim.z;
    unsigned sum, cnt, mine, sp = 0u;
    for (;;) {
        sum = 0u; cnt = 0u; mine = 0u;
#pragma unroll
        for (unsigned j = 0; j < 16; ++j) { const unsigned c = xb_ld(&bar[XB_XCNT(j)]); sum += c; cnt += (c > 0u) ? 1u : 0u; mine = (j == x) ? c : mine; }
        if (sum == G) break;
        __builtin_amdgcn_s_sleep(1);
        if ((++sp & 255u) == 0u) { if (xb_ld(&bar[XB_TMO])) break; if (sp > XB_SPIN_CAP) { atomicAdd(&bar[XB_TMO], 1u); break; } }
    }
    nloc = mine > 0u ? mine : 1u; nx = cnt > 0u ? cnt : 1u;
}

__device__ __forceinline__ void xcd_barrier(const XcdBarrier& b) {
    asm volatile("s_waitcnt vmcnt(0)" ::: "memory");
    __syncthreads();
    if (threadIdx.x == 0) {
        unsigned* bar = b.bar;
        __builtin_amdgcn_s_waitcnt(0);
        unsigned nloc = b.st[0], nx = b.st[1];
        if (nloc == 0u) { xcd_barrier_complete(bar, b.x, nloc, nx); b.st[0] = nloc; b.st[1] = nx; }
        const unsigned old = xb_add(&bar[XB_XSUB(b.x)], 1u);
        const unsigned gen = old / nloc;
        if (old + 1u == (gen + 1u) * nloc) {
            __builtin_amdgcn_fence(__ATOMIC_RELEASE, "agent");
            asm volatile("s_waitcnt vmcnt(0)" ::: "memory");
            const unsigned og = xb_add(&bar[XB_TOP], 1u);
            const unsigned tg = og / nx;
            if (og + 1u == (tg + 1u) * nx) xb_add(&bar[XB_TOPGEN], 1u);
            else XB_SPIN(xb_ld(&bar[XB_TOPGEN]) == tg, bar);
            __builtin_amdgcn_fence(__ATOMIC_ACQUIRE, "agent");
            xb_add(&bar[XB_XGEN(b.x)], 1u);
            asm volatile("s_waitcnt vmcnt(0)" ::: "memory");
        } else {
            XB_SPIN(xb_ld(&bar[XB_XGEN(b.x)]) == gen, bar);
            __builtin_amdgcn_fence(__ATOMIC_ACQUIRE, "agent");
            asm volatile("s_waitcnt vmcnt(0)" ::: "memory");
        }
    }
    __syncthreads();
}
__device__ __forceinline__ void compress_task(const Args& a, char* lds, int task) {
    const int tid = threadIdx.x, wid = __builtin_amdgcn_readfirstlane(tid >> 6), lane = tid & 63, l15 = lane & 15, lq = lane >> 4;
    unsigned char* ws = a.ws;
    const int ct = task & 7, kvh = (task >> 3) & 1, b = (task >> 4) & 3, wh = task >> 6;
    const f16* PROJ = (const f16*)(ws + WS_PROJ);
    const f16* W1T = (const f16*)(ws + WS_W1T) + (size_t)wh * 128 * 4096; const f16* W2T = (const f16*)(ws + WS_W2T) + (size_t)wh * 128 * 128;
    const float* B1 = (const float*)(ws + WS_B1) + wh * 128;
    const int col = (wh == 0 ? C_NK : C_NV) + kvh * 128;
    const int c = ct * 16 + l15;
    const f16* wrow = W1T + (size_t)(wid * 16 + l15) * 4096 + lq * 8;
    f32x4 acc = {0.f, 0.f, 0.f, 0.f};
#pragma unroll 8
    for (int ks = 0; ks < 128; ++ks) {
        int tok = 16 * c + (ks >> 2); tok = tok > SEQ - 1 ? SEQ - 1 : tok;
        const h8 av = *(const h8*)(PROJ + (size_t)(b * SEQ + tok) * NP + col + (ks & 3) * 32 + lq * 8);
        const h8 bv = *(const h8*)(wrow + ks * 32);
        acc = __builtin_amdgcn_mfma_f32_16x16x32_f16(av, bv, acc, 0, 0, 0);
    }
    f16* hid = (f16*)lds;
    float* ssq = (float*)(lds + 4096);
    { const float bb = B1[wid * 16 + l15];
#pragma unroll
      for (int i = 0; i < 4; ++i) hid[(4 * lq + i) * 128 + wid * 16 + l15] = (f16)silu_f(acc[i] + bb); }
    __syncthreads();
    f32x4 acc2 = {0.f, 0.f, 0.f, 0.f};
#pragma unroll
    for (int s = 0; s < 4; ++s) {
        const h8 av = *(const h8*)(hid + l15 * 128 + s * 32 + lq * 8);
        const h8 bv = *(const h8*)(W2T + (size_t)(wid * 16 + l15) * 128 + s * 32 + lq * 8);
        acc2 = __builtin_amdgcn_mfma_f32_16x16x32_f16(av, bv, acc2, 0, 0, 0);
    }
    float rs[4] = {1.f, 1.f, 1.f, 1.f};
    if (wh == 0) {
#pragma unroll
        for (int i = 0; i < 4; ++i) { float s = acc2[i] * acc2[i]; s += __shfl_xor(s, 1); s += __shfl_xor(s, 2); s += __shfl_xor(s, 4); s += __shfl_xor(s, 8);
            if (l15 == 0) ssq[wid * 16 + 4 * lq + i] = s; }
    }
    __syncthreads();
    if (wh == 0) {
        const float gn = a.in[I_NKG][wid * 16 + l15];
#pragma unroll
        for (int i = 0; i < 4; ++i) { float s = 0.f;
#pragma unroll
            for (int w = 0; w < 8; ++w) s += ssq[w * 16 + 4 * lq + i];
            rs[i] = rsqrtf(s * (1.f / 128.f) + EPS) * gn; }
    }
    f16* dst = (f16*)(ws + (wh == 0 ? WS_KC : WS_VC)) + (size_t)(b * 2 + kvh) * 128 * 128;
#pragma unroll
    for (int i = 0; i < 4; ++i) { const int cr = ct * 16 + 4 * lq + i; dst[(size_t)cr * 128 + wid * 16 + l15] = cr < NCMP ? (f16)(acc2[i] * rs[i]) : (f16)0.f; }
    __syncthreads();
}
namespace att {
constexpr int KVBLK = 64, SHM_K = 16384, SHM_V = 16384;
constexpr int L_V = 0, L_K = 32768, L_WSF = 65536, L_KB = 67584, L_TBL = 68096, L_SELM = 72192, L_UNION = 72448, L_TL = 72512, L_IMPH = 73728, L_END = 107520;
constexpr float C2 = LOG2E * SCALE, THR2 = 8.f * LOG2E;
#define KSWZ(row, colB) ((row) * 256 + ((colB) ^ (((row) & 7) << 4)))
#define SBAR() __builtin_amdgcn_sched_barrier(0)
__device__ __forceinline__ int v_st(int k, int c) { const int kk = (k & ~0xC) | ((k & 4) << 1) | ((k & 8) >> 1); return ((kk >> 3) * 4 + (c >> 5)) * 512 + ((kk & 7) * 32 + (c & 31)) * 2; }
__device__ __forceinline__ int v_rd_base(int lane) { return ((lane & 3) << 3) | (((lane >> 2) & 3) << 6) | (((lane >> 4) & 1) << 5) | (((lane >> 5) & 1) << 8); }
constexpr int v_rd_off(int d0, int ks, int half) { return d0 * 512 + ks * 4096 + half * 2048; }
__device__ __forceinline__ int crow(int r, int hi) { return (r & 3) + 8 * (r >> 2) + 4 * hi; }
__device__ __forceinline__ unsigned cvtpk(float lo, float hi) { h2 v; v.x = (f16)lo; v.y = (f16)hi; return __builtin_bit_cast(unsigned, v); }
typedef short s16x4 __attribute__((ext_vector_type(4)));

__device__ __forceinline__ void qkt(f32x16& p0, f32x16& p1, const char* K_lds, int r32, int hi, const h8* qr) {
    p0 = f32x16{}; p1 = f32x16{};
    const char* kb[4];
#pragma unroll
    for (int dd = 0; dd < 4; ++dd) kb[dd] = K_lds + KSWZ(r32, (dd * 16 + hi * 8) * 2);
#pragma unroll
    for (int d0 = 0; d0 < 8; ++d0) { const char* a = kb[d0 & 3] + (d0 >> 2) * 128;
        const h8 b0 = *reinterpret_cast<const h8*>(a);
        const h8 b1 = *reinterpret_cast<const h8*>(a + 32 * 256);
        p0 = __builtin_amdgcn_mfma_f32_32x32x16_f16(b0, qr[d0], p0, 0, 0, 0);
        p1 = __builtin_amdgcn_mfma_f32_32x32x16_f16(b1, qr[d0], p1, 0, 0, 0);
        if (d0 == 3) SBAR(); }
}
__device__ __forceinline__ void pv_tile(f32x16* o, int vb0, h8 pa0, h8 pa1, h8 pa2, h8 pa3) {
#define TRRD(dst, off) asm volatile("ds_read_b64_tr_b16 %0, %1 offset:%2" : "=&v"(dst) : "v"(vb0), "i"(off) : "memory")
#define PV_D0(d0) do { s16x4 l0, l1, l2, l3, g0, g1, g2, g3; constexpr int b_ = v_rd_off(d0, 0, 0); \
        TRRD(l0, b_); TRRD(g0, b_ + 2048); TRRD(l1, b_ + 4096); TRRD(g1, b_ + 6144); TRRD(l2, b_ + 8192); TRRD(g2, b_ + 10240); TRRD(l3, b_ + 12288); TRRD(g3, b_ + 14336); \
        asm volatile("s_waitcnt lgkmcnt(0)" ::: "memory"); SBAR(); \
        o[d0] = __builtin_amdgcn_mfma_f32_32x32x16_f16(pa0, __builtin_bit_cast(h8, (short __attribute__((ext_vector_type(8)))){l0[0], l0[1], l0[2], l0[3], g0[0], g0[1], g0[2], g0[3]}), o[d0], 0, 0, 0); \
        o[d0] = __builtin_amdgcn_mfma_f32_32x32x16_f16(pa1, __builtin_bit_cast(h8, (short __attribute__((ext_vector_type(8)))){l1[0], l1[1], l1[2], l1[3], g1[0], g1[1], g1[2], g1[3]}), o[d0], 0, 0, 0); \
        o[d0] = __builtin_amdgcn_mfma_f32_32x32x16_f16(pa2, __builtin_bit_cast(h8, (short __attribute__((ext_vector_type(8)))){l2[0], l2[1], l2[2], l2[3], g2[0], g2[1], g2[2], g2[3]}), o[d0], 0, 0, 0); \
        o[d0] = __builtin_amdgcn_mfma_f32_32x32x16_f16(pa3, __builtin_bit_cast(h8, (short __attribute__((ext_vector_type(8)))){l3[0], l3[1], l3[2], l3[3], g3[0], g3[1], g3[2], g3[3]}), o[d0], 0, 0, 0); } while (0)
    PV_D0(0); PV_D0(1); PV_D0(2); PV_D0(3);
#undef PV_D0
#undef TRRD
}
__device__ __forceinline__ void partialSM(f32x16& p0, f32x16& p1, float& m_reg, float& mn, float& alpha) {
    float pmax = p0[0];
#pragma unroll
    for (int r = 1; r < 16; ++r) pmax = fmaxf(pmax, p0[r]);
#pragma unroll
    for (int r = 0; r < 16; ++r) pmax = fmaxf(pmax, p1[r]);
    { auto rr = __builtin_amdgcn_permlane32_swap(__float_as_uint(pmax), __float_as_uint(pmax), false, false);
      pmax = fmaxf(__uint_as_float(rr[0]), __uint_as_float(rr[1])); }
    if (__builtin_expect(__all((pmax - m_reg) <= THR2), 1)) { mn = m_reg; alpha = 1.f; }
    else { mn = fmaxf(m_reg, pmax); alpha = __builtin_amdgcn_exp2f(m_reg - mn); m_reg = mn; }
#pragma unroll
    for (int r = 0; r < 16; ++r) p0[r] = __builtin_amdgcn_exp2f(p0[r] - mn);
}
__device__ __forceinline__ void finishSM(f32x16& p0, f32x16& p1, float mn, float alpha, float& l_reg, h8& pa0, h8& pa1, h8& pa2, h8& pa3) {
#pragma unroll
    for (int r = 0; r < 16; ++r) p1[r] = __builtin_amdgcn_exp2f(p1[r] - mn);
    float ps = 0;
#pragma unroll
    for (int r = 0; r < 16; ++r) ps += p0[r];
#pragma unroll
    for (int r = 0; r < 16; ++r) ps += p1[r];
    { auto rr = __builtin_amdgcn_permlane32_swap(__float_as_uint(ps), __float_as_uint(ps), false, false);
      ps = __uint_as_float(rr[0]) + __uint_as_float(rr[1]); }
    l_reg = l_reg * alpha + ps;
#define PK4(P, B_, OUT) do { unsigned a0 = cvtpk(P[B_+0], P[B_+1]), a1 = cvtpk(P[B_+2], P[B_+3]); \
        unsigned b0 = cvtpk(P[B_+4], P[B_+5]), b1 = cvtpk(P[B_+6], P[B_+7]); \
        auto r0 = __builtin_amdgcn_permlane32_swap(a0, b0, false, false); auto r1 = __builtin_amdgcn_permlane32_swap(a1, b1, false, false); \
        u32x4 w = {r0[0], r1[0], r0[1], r1[1]}; OUT = __builtin_bit_cast(h8, w); } while (0)
    PK4(p0, 0, pa0); PK4(p0, 8, pa1); PK4(p1, 0, pa2); PK4(p1, 8, pa3);
#undef PK4
}
__device__ __forceinline__ void mask_tile(f32x16& p0, f32x16& p1, int dq, unsigned W) {
    const float NEG = -__builtin_inff();
#pragma unroll
    for (int r = 0; r < 16; ++r) { const int c = (r & 3) + 8 * (r >> 2);
        if ((unsigned)(dq - c) >= W) p0[r] = NEG;
        if ((unsigned)(dq - c - 32) >= W) p1[r] = NEG; }
}
__device__ __forceinline__ void t5_bias(f32x16& p0, f32x16& p1, int dq, const float* tb) {
#pragma unroll
    for (int r = 0; r < 16; ++r) { const int c = (r & 3) + 8 * (r >> 2);
        int d0 = dq - c, d1 = dq - c - 32;
        d0 = d0 < 0 ? 0 : (d0 > 127 ? 127 : d0); d1 = d1 < 0 ? 0 : (d1 > 127 ? 127 : d1);
        p0[r] += tb[d0]; p1[r] += tb[d1];
        if ((r & 3) == 3) SBAR(); }
}

enum { M_FOX = 0, M_SEL = 1, M_WIN = 2, M_CMP = 3 };
struct Run {
    const f16* K; const f16* V; int ldk;
    const float* kbias;
    int P0;
    int ntiles;
    f16* O;
};

template <int MODE>
__device__ __forceinline__ void run_tiles(const Run R, char* lds, const h8 (&qr)[8], int qlo, const float* tb, unsigned selrow, const int tid) {
    const int wid = __builtin_amdgcn_readfirstlane(tid >> 6), lane = tid & 63, r32 = lane & 31, hi = lane >> 5;
    char* V_lds = lds + L_V; char* K_lds = lds + L_K;
    float* wsf = (float*)(lds + L_WSF) + wid * 64; float* li_l = wsf, * al_l = wsf + 32;
    float* KBl = (float*)(lds + L_KB);
    const int* TL = (const int*)(lds + L_TL);
    const int vb0 = (int)(uintptr_t)V_lds + v_rd_base(lane);
    float m_reg = -1e30f, l_reg = 0.f; f32x16 o[4] = {};
    const int NTL = R.ntiles;
    int koff[2], voff[2];
#pragma unroll
    for (int i = 0; i < 2; ++i) { const int q = (wid * 2 + i) * 64 + lane;
        { const int row = q >> 4, ch = (q & 15) ^ (row & 7); koff[i] = row * R.ldk + ch * 8; }
        { const int sub = q >> 5, r16 = q & 31, kk = (sub >> 2) * 8 + (r16 >> 2), c = (sub & 3) * 32 + (r16 & 3) * 8;
          const int k = (kk & ~0xC) | ((kk & 4) << 1) | ((kk & 8) >> 1); voff[i] = k * R.ldk + c; } }
    float skb = 0.f;
#define ISSUE(j, bf) do { const f16* kt_ = R.K + (size_t)((j) * KVBLK) * R.ldk; const f16* vt_ = R.V + (size_t)((j) * KVBLK) * R.ldk; \
        _Pragma("unroll") for (int i_ = 0; i_ < 2; ++i_) { \
            __builtin_amdgcn_global_load_lds((const unsigned*)(kt_ + koff[i_]), (LAS unsigned*)(uintptr_t)(unsigned)((int)(uintptr_t)K_lds + (bf) * SHM_K + (wid * 2 + i_) * 1024), 16, 0, 0); \
            __builtin_amdgcn_global_load_lds((const unsigned*)(vt_ + voff[i_]), (LAS unsigned*)(uintptr_t)(unsigned)((int)(uintptr_t)V_lds + (bf) * SHM_V + (wid * 2 + i_) * 1024), 16, 0, 0); } \
        if (MODE == M_FOX) { if (tid < 64) skb = -R.kbias[(j) * KVBLK + tid] * LOG2E; } } while (0)
    if (NTL > 0) ISSUE(TL[0], 0);
#pragma unroll 1
    for (int t = 0; t < NTL; ++t) {
        const int buf = t & 1, j = TL[t];
        if (MODE == M_FOX) { if (tid < 64) KBl[buf * 64 + tid] = skb; }
        asm volatile("s_waitcnt vmcnt(0)" ::: "memory");
        __syncthreads();
        if (t + 1 < NTL) ISSUE(TL[t + 1], buf ^ 1);
        f32x16 p0, p1;
        const int kb_ = (MODE == M_CMP) ? 0 : j * KVBLK;
        {
            qkt(p0, p1, K_lds + buf * SHM_K, r32, hi, qr);
            if (MODE == M_FOX) {
                const float* kbp = KBl + buf * 64 + 4 * hi;
#pragma unroll
                for (int g = 0; g < 4; ++g) { const f32x4 b0 = *(const f32x4*)(kbp + 8 * g), b1 = *(const f32x4*)(kbp + 32 + 8 * g);
#pragma unroll
                    for (int i = 0; i < 4; ++i) { p0[4 * g + i] = fmaf(p0[4 * g + i], C2, b0[i]); p1[4 * g + i] = fmaf(p1[4 * g + i], C2, b1[i]); } }
                if (kb_ + KVBLK - 1 > qlo) mask_tile(p0, p1, qlo + r32 - 4 * hi - kb_, 0x7fffffffu);
            } else if (MODE == M_CMP) {
#pragma unroll
                for (int r = 0; r < 16; ++r) { p0[r] *= C2; p1[r] *= C2; }
                const int dq3 = qlo + r32 - 31 - 16 * (j * 64 + 4 * hi);
                const float NEG = -__builtin_inff();
                const bool near = (qlo - 31 - 16 * (j * 64 + 63)) < 113;
#pragma unroll
                for (int r = 0; r < 16; ++r) { const int c = (r & 3) + 8 * (r >> 2); const int d0 = dq3 - 16 * c, d1 = d0 - 512;
                    if (near) { p0[r] += tb[d0 < 0 ? 0 : (d0 > 127 ? 127 : d0)]; p1[r] += tb[d1 < 0 ? 0 : (d1 > 127 ? 127 : d1)]; }
                    if (d0 < 0) p0[r] = NEG; if (d1 < 0) p1[r] = NEG;
                    if ((r & 3) == 3) SBAR(); }
            } else {
#pragma unroll
                for (int r = 0; r < 16; ++r) { p0[r] *= C2; p1[r] *= C2; }
                const int dq = qlo + r32 - 4 * hi - kb_;
                if (qlo - (kb_ + KVBLK - 1) < 113) t5_bias(p0, p1, dq, tb);
                if (MODE == M_SEL) { if (kb_ + KVBLK - 1 > qlo) mask_tile(p0, p1, dq, 0x7fffffffu);
                    if (!((selrow >> j) & 1u)) { const float NEG = -__builtin_inff();
#pragma unroll
                        for (int r = 0; r < 16; ++r) { p0[r] = NEG; p1[r] = NEG; } } }
                else { if (kb_ + KVBLK - 1 > qlo || kb_ <= qlo + 31 - WIN) mask_tile(p0, p1, dq, (unsigned)WIN); }
            }
            float mn, alpha; h8 pa0, pa1, pa2, pa3;
            partialSM(p0, p1, m_reg, mn, alpha);
            finishSM(p0, p1, mn, alpha, l_reg, pa0, pa1, pa2, pa3);
            if (__any(alpha < 1.f)) { if (hi == 0) al_l[r32] = alpha; asm volatile("s_waitcnt lgkmcnt(0)" ::: "memory");
#pragma unroll
                for (int d_ = 0; d_ < 4; ++d_)
#pragma unroll
                    for (int r = 0; r < 16; ++r) o[d_][r] *= al_l[crow(r, hi)]; }
            SBAR();
            pv_tile(o, vb0 + buf * SHM_V, pa0, pa1, pa2, pa3);
        }
    }
#undef ISSUE
    if (hi == 0) li_l[r32] = l_reg; asm volatile("s_waitcnt lgkmcnt(0)" ::: "memory");
    f16* Ow = R.O + (size_t)(qlo - R.P0) * 1024;
#pragma unroll
    for (int r = 0; r < 16; ++r) { const int orow = crow(r, hi); const float lv = li_l[orow]; const float rl = lv > 0.f ? __builtin_amdgcn_rcpf(lv) : 0.f;
#pragma unroll
        for (int d0 = 0; d0 < 4; ++d0) { const float v = o[d0][r] * rl; const float vn = __shfl_xor(v, 1);
            if ((r32 & 1) == 0) *(unsigned*)(Ow + (size_t)orow * 1024 + d0 * 32 + r32) = cvtpk(v, vn); } }
    __syncthreads();
}

__device__ __forceinline__ int fill_tiles_range(char* lds, int j_lo, int j_hi, int tid) {
    int* TL = (int*)(lds + L_TL);
    if (tid < j_hi - j_lo) TL[tid] = j_lo + tid;
    __syncthreads();
    return j_hi - j_lo;
}

__device__ __forceinline__ void fox_unit(const Args& a, char* lds, int b, int h, int qt) {
    int tid_ = threadIdx.x; asm volatile("" : "+v"(tid_));
    const int tid = tid_, wid = __builtin_amdgcn_readfirstlane(tid >> 6), lane = tid & 63, r32 = lane & 31, hi = lane >> 5;
    unsigned char* wsb = a.ws; asm volatile("" : "+s"(wsb));
    const f16* PROJ = (const f16*)(wsb + WS_PROJ);
    const int P0 = qt * 256, qlo = P0 + wid * 32;
    h8 qr[8];
    { const f16* qp = PROJ + (size_t)(b * SEQ + qlo + r32) * NP + C_FQ + h * 128 + hi * 8;
#pragma unroll
      for (int d0 = 0; d0 < 8; ++d0) qr[d0] = *(const h8*)(qp + d0 * 16); }
    Run R; R.K = PROJ + (size_t)(b * SEQ) * NP + C_FK + h * 128; R.V = PROJ + (size_t)(b * SEQ) * NP + C_FV + h * 128; R.ldk = NP;
    R.kbias = (const float*)(wsb + WS_CUM) + (size_t)(b * 8 + h) * SEQ; R.P0 = P0;
    R.O = (f16*)(wsb + WS_OF) + (size_t)(b * SEQ + P0) * 1024 + h * 128;
    R.ntiles = fill_tiles_range(lds, 0, (P0 + 255) / KVBLK + 1, tid);
    run_tiles<M_FOX>(R, lds, qr, qlo, nullptr, 0u, tid);
}

__device__ __forceinline__ unsigned topk_mask32(const float (&impin)[32], int t) {
    float v[32]; const int cur = t >> 6;
#pragma unroll
    for (int j = 0; j < 32; ++j) { float x = impin[j]; if (j == 0 || j == cur || j == cur - 1) x = 1e6f; if (j > cur) x = -__builtin_inff(); v[j] = x; }
    unsigned mask = 0u;
#pragma unroll 1
    for (int it = 0; it < NSEL; ++it) { float best = -__builtin_inff(); int bi = -1;
#pragma unroll
        for (int j = 0; j < 32; ++j) if (v[j] > best) { best = v[j]; bi = j; }
        if (bi < 0) break;
        mask |= 1u << bi;
#pragma unroll
        for (int j = 0; j < 32; ++j) if (j == bi) v[j] = -__builtin_inff(); }
    return mask;
}
__device__ __forceinline__ void nsa_unit(const Args& a, char* lds, int b, int kvh, int qt) {
    int tid_ = threadIdx.x; asm volatile("" : "+v"(tid_));
    const int tid = tid_, wid = __builtin_amdgcn_readfirstlane(tid >> 6), lane = tid & 63, r32 = lane & 31, hi = lane >> 5;
    unsigned char* wsb = a.ws; asm volatile("" : "+s"(wsb));
    const f16* PROJ = (const f16*)(wsb + WS_PROJ);
    const int P0 = qt * 64, qlo = P0 + (wid >> 2) * 32, g4 = wid & 3, hq = kvh * 4 + g4;
    const float* tb = (const float*)(lds + L_TBL) + hq * 128;
    h8 qr[8];
    { const f16* qp = PROJ + (size_t)(b * SEQ + qlo + r32) * NP + C_NQ + hq * 128 + hi * 8;
#pragma unroll
      for (int d0 = 0; d0 < 8; ++d0) qr[d0] = *(const h8*)(qp + d0 * 16); }
    const f16* KC = (const f16*)(wsb + WS_KC) + (size_t)(b * 2 + kvh) * 128 * 128; const f16* VC = (const f16*)(wsb + WS_VC) + (size_t)(b * 2 + kvh) * 128 * 128;
#ifndef NSA_SKIP_A
    {
        char* K_lds = lds + L_K;
        const int sr = tid >> 4, sc = (tid & 15) * 8, kws = KSWZ(sr, sc * 2);
#pragma unroll
        for (int T = 0; T < 2; ++T) { *(h8*)(K_lds + T * SHM_K + kws) = *(const h8*)(KC + (size_t)(T * 64 + sr) * 128 + sc);
            *(h8*)(K_lds + T * SHM_K + kws + 32 * 256) = *(const h8*)(KC + (size_t)(T * 64 + 32 + sr) * 128 + sc); }
        __syncthreads();
        f32x16 x[4];
        qkt(x[0], x[1], K_lds, r32, hi, qr); qkt(x[2], x[3], K_lds + SHM_K, r32, hi, qr);
        const float NEG = -__builtin_inff();
        float mx = NEG;
#pragma unroll
        for (int T = 0; T < 2; ++T) { const int dq3 = qlo + r32 - 31 - 16 * (T * 64 + 4 * hi);
#pragma unroll
            for (int r = 0; r < 16; ++r) { const int c = (r & 3) + 8 * (r >> 2); const int d0 = dq3 - 16 * c, d1 = d0 - 512;
                float v0 = x[2 * T][r] * C2 + tb[d0 < 0 ? 0 : (d0 > 127 ? 127 : d0)], v1 = x[2 * T + 1][r] * C2 + tb[d1 < 0 ? 0 : (d1 > 127 ? 127 : d1)];
                if (d0 < 0) v0 = NEG; if (d1 < 0) v1 = NEG;
                x[2 * T][r] = v0; x[2 * T + 1][r] = v1; mx = fmaxf(mx, fmaxf(v0, v1)); } }
        mx = fmaxf(mx, __shfl_xor(mx, 32));
        const float mref = mx == NEG ? 0.f : mx;
        float sum = 0.f;
#pragma unroll
        for (int q = 0; q < 4; ++q)
#pragma unroll
            for (int r = 0; r < 16; ++r) { const float e = __builtin_amdgcn_exp2f(x[q][r] - mref); x[q][r] = e; sum += e; }
        sum += __shfl_xor(sum, 32);
        const float inv = sum > 0.f ? 1.f / sum : 0.f;
        float own[16], cout[16], cin[16];
#pragma unroll
        for (int q = 0; q < 4; ++q)
#pragma unroll
            for (int g = 0; g < 4; ++g) { const float e0 = x[q][4 * g], e1 = x[q][4 * g + 1], e2 = x[q][4 * g + 2], e3 = x[q][4 * g + 3];
                own[4 * q + g] = (2.f * (e0 + e1 + e2) + e3) * inv; cout[4 * q + g] = e3 * inv; }
#pragma unroll
        for (int k = 0; k < 16; ++k) cin[k] = __shfl_xor(cout[k], 32);
        float* IMPH = (float*)(lds + L_IMPH) + (size_t)(g4 * 64 + (wid >> 2) * 32 + r32) * 33;
#pragma unroll
        for (int k = 0; k < 16; ++k) { const float ci = hi ? cin[k] : (k > 0 ? cin[k - 1] : 0.f);
            const int q = k >> 2, g = k & 3, j = 16 * (q >> 1) + 8 * (q & 1) + 2 * g + hi;
            IMPH[j] = own[k] + ci; }
        __syncthreads();
        if (tid < 64) { const float* ip = (const float*)(lds + L_IMPH) + tid * 33; float imp[32];
#pragma unroll
            for (int j = 0; j < 32; ++j) imp[j] = ((ip[j] + ip[64 * 33 + j]) + ip[2 * 64 * 33 + j]) + ip[3 * 64 * 33 + j];
            unsigned m = topk_mask32(imp, P0 + tid);
            ((unsigned*)(lds + L_SELM))[tid] = m;
#pragma unroll
            for (int o_ = 1; o_ < 64; o_ <<= 1) m |= __shfl_xor(m, o_);
            if (tid == 0) *(unsigned*)(lds + L_UNION) = m; }
        __syncthreads();
    }
#endif
    const unsigned selrow = ((const unsigned*)(lds + L_SELM))[(wid >> 2) * 32 + r32];
    const unsigned uni = *(const unsigned*)(lds + L_UNION);
    Run R; R.kbias = nullptr; R.P0 = P0;
    const size_t obase = (size_t)(b * SEQ + P0) * 1024 + hq * 128;
    R.K = KC; R.V = VC; R.ldk = 128; R.O = (f16*)(wsb + WS_OC) + obase; R.ntiles = fill_tiles_range(lds, 0, 2, tid);
#ifndef NSA_SKIP_CMP
    run_tiles<M_CMP>(R, lds, qr, qlo, tb, 0u, tid);
#endif
    { int* TL = (int*)(lds + L_TL);
      if (tid == 0) { int n = 0; for (int j = 0; j < 32; ++j) if ((uni >> j) & 1u) TL[n++] = j; TL[39] = n; }
      __syncthreads(); }
    R.K = PROJ + (size_t)(b * SEQ) * NP + C_NK + 256 + kvh * 128; R.V = PROJ + (size_t)(b * SEQ) * NP + C_NV + 256 + kvh * 128; R.ldk = NP;
    R.O = (f16*)(wsb + WS_OS) + obase; R.ntiles = ((const int*)(lds + L_TL))[39];
#ifndef NSA_SKIP_SEL
    run_tiles<M_SEL>(R, lds, qr, qlo, tb, selrow, tid);
#endif
    { int jl = (P0 - (WIN - 1)); jl = jl > 0 ? jl / KVBLK : 0;
      R.K = PROJ + (size_t)(b * SEQ) * NP + C_NK + 512 + kvh * 128; R.V = PROJ + (size_t)(b * SEQ) * NP + C_NV + 512 + kvh * 128;
      R.O = (f16*)(wsb + WS_OW) + obase; R.ntiles = fill_tiles_range(lds, jl, (P0 + 63) / KVBLK + 1, tid);
#ifndef NSA_SKIP_WIN
      run_tiles<M_WIN>(R, lds, qr, qlo, tb, 0u, tid);
#endif
    }
}

__device__ __forceinline__ void attn_phase(const Args& a, char* lds, int bid, int nblk) {
    { const float* TBLR = (const float*)(a.ws + WS_TBL) + 1024; float* t = (float*)(lds + L_TBL);
      for (int i = threadIdx.x; i < 1024; i += NT) t[i] = TBLR[i] * LOG2E; }
    __syncthreads();
    for (int i = bid; i < 256; i += nblk) {
        const int qt_f = i & 7, k = (i >> 3) & 3, bh_f = i >> 3, rest = i >> 5, qt_n = 31 - 4 * qt_f - k;
        fox_unit(a, lds, bh_f >> 3, bh_f & 7, qt_f);
        nsa_unit(a, lds, rest >> 1, rest & 1, qt_n);
    }
}
#undef KSWZ
#undef SBAR
}
constexpr int LDS_BYTES = 147456;
constexpr int LDSCTL_OFF = 131072, MISC_OFF = LDSCTL_OFF + 320;
constexpr int CW_BAR = 4096;
constexpr int N_PHASES = 10;

__device__ __forceinline__ void gemm_stage(const Args& a, LAS unsigned char* lds, int stage) {
    unsigned char* ws = a.ws; const float* MOD = (const float*)(ws + WS_MOD);
    pg8::StaticOrder S;
    if (stage == 2) { pg8::Gemm g{(const f16*)(ws + WS_H), (const f16*)(ws + WS_WIN), NTOK, NP, DM}; S.init(NTOK, NP, gridDim.x, blockIdx.x);
        pg8::EpiProj E{(f16*)(ws + WS_PROJ), NP}; pg8::gemm_phase<pg8::EpiProj, pg8::StaticOrder, PG8_ALIGN, PG8_SP2>(lds, g, S, E); }
    else if (stage == 6) { pg8::Gemm g{(const f16*)(ws + WS_H), (const f16*)(ws + WS_WOUT), NTOK, DM, DM}; S.init(NTOK, DM, gridDim.x, blockIdx.x);
        pg8::EpiRes E{a.in[I_X], a.out, MOD + 2 * DM}; pg8::gemm_phase<pg8::EpiRes, pg8::StaticOrder, PG8_ALIGN, PG8_SP2>(lds, g, S, E); }
    else if (stage == 8) { pg8::Gemm g{(const f16*)(ws + WS_H), (const f16*)(ws + WS_WGU), NTOK, NGU, DM}; S.init(NTOK, NGU, gridDim.x, blockIdx.x);
        pg8::EpiGU E{(f16*)(ws + WS_PROJ)}; pg8::gemm_phase<pg8::EpiGU, pg8::StaticOrder, PG8_ALIGN, PG8_SP2>(lds, g, S, E); }
    else { pg8::Gemm g{(const f16*)(ws + WS_PROJ), (const f16*)(ws + WS_WDN), NTOK, DM, DFF}; S.init(NTOK, DM, gridDim.x, blockIdx.x);
        pg8::EpiRes E{a.out, a.out, MOD + 5 * DM}; pg8::gemm_phase<pg8::EpiRes, pg8::StaticOrder, PG8_ALIGN, PG8_SP2>(lds, g, S, E); }
}

__global__ void __launch_bounds__(NT, 2) k_mega(Args a) {
    extern __shared__ __attribute__((aligned(16))) unsigned char lds_raw[];
    LAS char* lds = (LAS char*)lds_raw;
    const int bid = blockIdx.x, nblk = gridDim.x, tid = threadIdx.x;
    for (int u = tid; u < (LDS_BYTES - LDSCTL_OFF) / 4; u += NT) ((LAS unsigned*)(lds + LDSCTL_OFF))[u] = 0u;
    __syncthreads();
    unsigned* ctl = (unsigned*)(a.ws + WS_CTL);
    XcdBarrier bar = xcd_barrier_post(ctl + CW_BAR + a.li * XCD_BAR_WORDS, (volatile LAS unsigned*)(lds + MISC_OFF) + 8);
    const int lo = a.ph_lo, hi = a.ph_hi;
#define IN(k) (lo <= (k) && (k) < hi)
#define SEAM(k) do { if (IN(k) && IN((k) + 1)) xcd_barrier(bar); } while (0)
    if (IN(0)) { stage_prep(a, bid, nblk, lds); } SEAM(0);
    if (IN(1)) { stage_norm(a, bid, nblk, lds, 0); } SEAM(1);
    if (IN(2)) { gemm_stage(a, (LAS unsigned char*)lds_raw, 2); } SEAM(2);
    if (IN(3)) {
#if !NAIVE_ATTN
        for (int task = bid; task < 128; task += nblk) compress_task(a, (char*)lds_raw, task);
#endif
        post_norms(a, bid, nblk); post_cumsum(a, bid, nblk); } SEAM(3);
    if (IN(4)) {
#if !NAIVE_ATTN
        att::attn_phase(a, (char*)lds_raw, bid, nblk);
#endif
    } SEAM(4);
    if (IN(5)) { stage_ynorm(a, bid, nblk); } SEAM(5);
    if (IN(6)) { gemm_stage(a, (LAS unsigned char*)lds_raw, 6); } SEAM(6);
    if (IN(7)) { stage_norm(a, bid, nblk, lds, 1); } SEAM(7);
    if (IN(8)) { gemm_stage(a, (LAS unsigned char*)lds_raw, 8); } SEAM(8);
    if (IN(9)) { gemm_stage(a, (LAS unsigned char*)lds_raw, 9); }
#undef IN
#undef SEAM
}

extern "C" void kernel_launch(void* const* d_in, const int* in_sizes, int n_in, void* d_out, int out_size, void* d_ws, size_t ws_size, hipStream_t stream) {
    static int grid = 0;
    if (grid == 0) {
        if (n_in != 21 || out_size != NTOK * DM || ws_size < WS_END) { fprintf(stderr, "kernel_launch: unexpected problem (n_in %d out %d ws %zu)\n", n_in, out_size, ws_size); grid = -1; return; }
        int dev = 0, cus = 0, per_cu = 0;
        hipGetDevice(&dev); hipDeviceGetAttribute(&cus, hipDeviceAttributeMultiprocessorCount, dev);
        hipFuncSetAttribute((const void*)k_mega, hipFuncAttributeMaxDynamicSharedMemorySize, LDS_BYTES);
        if (hipOccupancyMaxActiveBlocksPerMultiprocessor(&per_cu, (const void*)k_mega, NT, LDS_BYTES) != hipSuccess || per_cu < 1) { fprintf(stderr, "kernel_launch: occupancy query says %d blocks per CU\n", per_cu); per_cu = 1; }
        (void)hipGetLastError();
        grid = (cus > 0 ? cus : 256) * 1;
    }
    if (grid < 0) return;
    hipMemsetAsync((char*)d_ws + WS_CTL, 0, CTL_BYTES, stream);
    Args a{};
    for (int i = 0; i < 21; ++i) a.in[i] = (const float*)d_in[i];
    a.out = (float*)d_out; a.ws = (unsigned char*)d_ws;
#define MEGA(lo_, hi_, li_) do { a.ph_lo = (lo_); a.ph_hi = (hi_); a.li = (li_); hipLaunchKernelGGL(k_mega, dim3(grid), dim3(NT), LDS_BYTES, stream, a); } while (0)
#if NAIVE_ATTN
    MEGA(0, 3, 0);
    hipLaunchKernelGGL(naive_compress, dim3(2048), dim3(128), 0, stream, a);
    MEGA(3, 4, 1);
    hipLaunchKernelGGL(naive_fox, dim3(256), dim3(256), 0, stream, a);
    hipLaunchKernelGGL(naive_cmp, dim3(256), dim3(256), 0, stream, a);
    hipLaunchKernelGGL(naive_topk, dim3(NTOK * 2 / 256), dim3(256), 0, stream, a);
    hipLaunchKernelGGL(naive_selwin, dim3(256), dim3(256), 0, stream, a);
    MEGA(5, 10, 2);
#elif PER_PHASE
    for (int p = 0; p < N_PHASES; ++p) MEGA(p, p + 1, 0);
#else
    MEGA(0, N_PHASES, 0);
#endif
#undef MEGA
}
```

```cpp
#include <hip/hip_runtime.h>
#include <cstdint>
#include <cstdio>

#define GAS __attribute__((address_space(1)))
#define LAS __attribute__((address_space(3)))
typedef _Float16 f16;
typedef _Float16 h8 __attribute__((ext_vector_type(8)));
typedef _Float16 h4 __attribute__((ext_vector_type(4)));
typedef _Float16 h2 __attribute__((ext_vector_type(2)));
typedef float f32x2 __attribute__((ext_vector_type(2)));
typedef float f32x4 __attribute__((ext_vector_type(4)));
typedef float f32x16 __attribute__((ext_vector_type(16)));
typedef unsigned u32x2 __attribute__((ext_vector_type(2)));
typedef unsigned u32x4 __attribute__((ext_vector_type(4)));

constexpr int NB = 4, SEQ = 2048, DM = 2048, NTOK = NB * SEQ, HD = 128;
constexpr int NFH = 8, NNH = 8, NKV = 2, GRP = 4;
constexpr int INW = 5664, NP = 5888, DFF = 5632, NGU = 2 * DFF, NMOD = 6 * DM;
constexpr int NCMP = 127, NSLC = 32, NSEL = 8, WIN = 512;
constexpr int C_FQ = 0, C_FK = 1024, C_FV = 2048, C_NQ = 3072, C_NK = 4096, C_NV = 4864, C_FF = 5632, C_NG = 5640;
constexpr float SCALE = 0.08838834764831845f, EPS = 1e-6f, LOG2E = 1.4426950408889634f;

constexpr size_t MiB = 1u << 20;
constexpr size_t WS_CTL = 0, CTL_BYTES = 1 * MiB;
constexpr size_t WS_MODP = 1 * MiB;
constexpr size_t WS_MOD = 2 * MiB;
constexpr size_t WS_CUM = 2 * MiB + 256 * 1024;
constexpr size_t WS_KC = 2 * MiB + 512 * 1024;
constexpr size_t WS_VC = 2 * MiB + 768 * 1024;
constexpr size_t WS_TBL = 3 * MiB;
constexpr size_t WS_B1 = 3 * MiB + 16 * 1024;
constexpr size_t WS_W2T = 3 * MiB + 64 * 1024;
constexpr size_t WS_W1T = 4 * MiB;
constexpr size_t WS_SEL = 6 * MiB;
constexpr size_t WS_WIN = 8 * MiB;
constexpr size_t WS_WOUT = 31 * MiB;
constexpr size_t WS_WGU = 39 * MiB;
constexpr size_t WS_WDN = 83 * MiB;
constexpr size_t WS_H = 105 * MiB;
constexpr size_t WS_PROJ = 137 * MiB;
constexpr size_t WS_OF = 229 * MiB, WS_OC = 245 * MiB, WS_OS = 261 * MiB, WS_OW = 277 * MiB;
constexpr size_t WS_SCR = 293 * MiB;
constexpr size_t WS_END = 325 * MiB;

struct Args {
    const float* in[21];
    float* out;
    unsigned char* ws;
    int ph_lo, ph_hi, li, pad;
};
enum { I_X = 0, I_C, I_ADAW, I_ADAB, I_G1, I_G2, I_WIN, I_FB, I_FQG, I_FKG, I_NQG, I_NKG, I_POS, I_W1, I_W2, I_RB, I_MOG, I_WOUT, I_WG, I_WU, I_WD };

__device__ __forceinline__ float wave_sum(float v) {
#pragma unroll
    for (int o = 1; o < 64; o <<= 1) v += __shfl_xor(v, o);
    return v;
}
__device__ __forceinline__ float silu_f(float x) { return x / (1.f + __expf(-x)); }
__device__ __forceinline__ float sigmoid_f(float x) { return 1.f / (1.f + __expf(-x)); }
__device__ __forceinline__ int t5_bucket(int d) {
    if (d < 16) return d < 0 ? 0 : d;
    const int thr[15] = {19, 21, 24, 27, 31, 35, 40, 46, 52, 59, 67, 77, 87, 99, 113};
    int b = 16;
#pragma unroll
    for (int i = 0; i < 15; ++i) b += (d >= thr[i]) ? 1 : 0;
    return b;
}
__device__ __forceinline__ int win_src_col(int n) {
    if (n < 3072) return n;
    if (n < 4096) return 3080 + (n - 3072);
    if (n < 4864) return 4104 + (n - 4096);
    if (n < 5632) return 4872 + (n - 4864);
    if (n < 5640) return 3072 + (n - 5632);
    if (n < 5664) return n;
    return -1;
}
constexpr int NT = 512, NWV = 8;

__device__ __forceinline__ void transpose_item(const float* W, const float* W2, int Nsrc, int K, f16* WT, int mode, LAS float* scr, int kb, int nb, int lane) {
    const int k0 = 64 * kb, n0 = 32 * nb;
    const int nl = n0 + (lane & 31);
    int sc; const float* src = W;
    if (mode == 0) sc = win_src_col(nl);
    else if (mode == 1) sc = nl;
    else { const int p = nl >> 8, r = nl & 255; sc = 128 * p + (r & 127); src = (r < 128) ? W : W2; }
    float v[32];
#pragma unroll
    for (int i = 0; i < 32; ++i) { const int kk = 2 * i + (lane >> 5); v[i] = (sc >= 0) ? __builtin_nontemporal_load(src + (size_t)(k0 + kk) * Nsrc + sc) : 0.f; }
#pragma unroll
    for (int i = 0; i < 32; ++i) { const int kk = 2 * i + (lane >> 5); scr[kk * 33 + (lane & 31)] = v[i]; }
    asm volatile("s_waitcnt lgkmcnt(0)" ::: "memory");
    const int c = lane & 7;
#pragma unroll
    for (int j = 0; j < 4; ++j) { const int n = (lane >> 3) + 8 * j; const LAS float* s = scr + (8 * c) * 33 + n;
        h8 o;
#pragma unroll
        for (int i = 0; i < 8; ++i) o[i] = (f16)s[i * 33];
        *(h8*)(WT + (size_t)(n0 + n) * K + k0 + 8 * c) = o; }
    asm volatile("s_waitcnt lgkmcnt(0)" ::: "memory");
}

__device__ __forceinline__ void stage_prep(const Args& a, int bid, int nblk, LAS char* lds) {
    const int tid = threadIdx.x, lane = tid & 63, wave = __builtin_amdgcn_readfirstlane(tid >> 6);
    unsigned char* ws = a.ws;
    {
        LAS float* scr = (LAS float*)(lds + wave * 8448);
        f16* WIN_T = (f16*)(ws + WS_WIN); f16* WOUT_T = (f16*)(ws + WS_WOUT); f16* WGU_T = (f16*)(ws + WS_WGU); f16* WDN_T = (f16*)(ws + WS_WDN);
        f16* W1T = (f16*)(ws + WS_W1T); f16* W2T = (f16*)(ws + WS_W2T);
        constexpr int I_IN = 32 * (NP / 32), I_OUT = 32 * (DM / 32), I_GU = 32 * (NGU / 32), I_DN = (DFF / 64) * (DM / 32), I_1 = 2 * 64 * 4, I_2 = 2 * 2 * 4;
        constexpr int NIT = I_IN + I_OUT + I_GU + I_DN + I_1 + I_2;
        const int gw = bid * NWV + wave, ngw = nblk * NWV;
        for (int it = gw; it < NIT; it += ngw) {
            int r = it;
            if (r < I_IN) { transpose_item(a.in[I_WIN], nullptr, INW, DM, WIN_T, 0, scr, r / (NP / 32), r % (NP / 32), lane); continue; } r -= I_IN;
            if (r < I_OUT) { transpose_item(a.in[I_WOUT], nullptr, DM, DM, WOUT_T, 1, scr, r / (DM / 32), r % (DM / 32), lane); continue; } r -= I_OUT;
            if (r < I_GU) { transpose_item(a.in[I_WG], a.in[I_WU], DFF, DM, WGU_T, 2, scr, r / (NGU / 32), r % (NGU / 32), lane); continue; } r -= I_GU;
            if (r < I_DN) { transpose_item(a.in[I_WD], nullptr, DM, DFF, WDN_T, 1, scr, r / (DM / 32), r % (DM / 32), lane); continue; } r -= I_DN;
            if (r < I_1) { const int wh = r / 256, q = r % 256; transpose_item(a.in[I_W1] + (size_t)wh * 4096 * 128, nullptr, 128, 4096, W1T + (size_t)wh * 128 * 4096, 1, scr, q / 4, q % 4, lane); continue; } r -= I_1;
            { const int wh = r / 8, q = r % 8; transpose_item(a.in[I_W2] + (size_t)wh * 128 * 128, nullptr, 128, 128, W2T + (size_t)wh * 128 * 128, 1, scr, q / 4, q % 4, lane); }
        }
    }
    __syncthreads();
    {
        LAS float* sc = (LAS float*)lds;
        LAS float* red = (LAS float*)(lds + 8192);
        float* MODP = (float*)(ws + WS_MODP);
        const float* cin = a.in[I_C]; const float* W = a.in[I_ADAW];
        const int tx = tid & 15, ty = tid >> 4;
        for (int it = bid; it < 192 * 4; it += nblk) {
            const int cc = it % 192, kc = it / 192, col0 = cc * 64, kbase = kc * 512;
            for (int i = tid; i < 4 * 512; i += NT) { const int b = i >> 9, k = i & 511; sc[i] = silu_f(cin[b * DM + kbase + k]); }
            __syncthreads();
            f32x4 acc[4] = {};
#pragma unroll 4
            for (int p = 0; p < 16; ++p) { const int kl = p * 32 + ty; const f32x4 w = *(const f32x4*)(W + (size_t)(kbase + kl) * NMOD + col0 + tx * 4);
#pragma unroll
                for (int b = 0; b < 4; ++b) acc[b] += w * sc[b * 512 + kl]; }
#pragma unroll
            for (int b = 0; b < 4; ++b) *(LAS f32x4*)(red + (ty * 4 + b) * 64 + tx * 4) = acc[b];
            __syncthreads();
            if (tid < 256) { const int b = tid >> 6, c = tid & 63; float s = 0.f;
#pragma unroll 8
                for (int y = 0; y < 32; ++y) s += red[(y * 4 + b) * 64 + c];
                MODP[((size_t)kc * 4 + b) * NMOD + col0 + c] = s; }
            __syncthreads();
        }
    }
    if (bid == 0) {
        float* TBL = (float*)(ws + WS_TBL); const float* rb = a.in[I_RB];
        for (int i = tid; i < 8 * 128; i += NT) { const int h = i >> 7, d = i & 127; const float v = rb[t5_bucket(d) * 8 + h]; TBL[i] = v; TBL[1024 + i] = v - rb[31 * 8 + h]; }
    }
    for (int it = bid; it < 64; it += nblk) {
        LAS float* red = (LAS float*)lds;
        const int wh = it >> 5, j = it & 31;
        const float* pos = a.in[I_POS] + wh * 4096 + j * 128; const float* w1 = a.in[I_W1] + ((size_t)wh * 4096 + j * 128) * 128;
        const int n = tid & 127, q = tid >> 7; float s = 0.f;
#pragma unroll 8
        for (int k = q; k < 128; k += 4) s += pos[k] * w1[(size_t)k * 128 + n];
        red[q * 128 + n] = s; __syncthreads();
        if (tid < 128) ((float*)(ws + WS_B1))[256 + it * 128 + tid] = red[tid] + red[128 + tid] + red[256 + tid] + red[384 + tid];
        __syncthreads();
    }
}

__device__ __forceinline__ void stage_norm(const Args& a, int bid, int nblk, LAS char* lds, int which) {
    const int tid = threadIdx.x, lane = tid & 63, wave = __builtin_amdgcn_readfirstlane(tid >> 6);
    unsigned char* ws = a.ws;
    const float* MODP = (const float*)(ws + WS_MODP); float* MOD = (float*)(ws + WS_MOD);
    const float* ada_b = a.in[I_ADAB];
    if (which == 0 && bid == 0 && tid < 256) {
        const float* B1P = (const float*)(ws + WS_B1) + 256; float s = 0.f; const int wh = tid >> 7, n = tid & 127;
        for (int j = 0; j < 32; ++j) s += B1P[(wh * 32 + j) * 128 + n];
        ((float*)(ws + WS_B1))[tid] = s; }
    if (which == 0) {
        for (int i = bid * NT + tid; i < 4 * NMOD; i += nblk * NT) { const int n = i % NMOD;
            MOD[i] = MODP[i] + MODP[4 * NMOD + i] + MODP[8 * NMOD + i] + MODP[12 * NMOD + i] + ada_b[n]; }
    }
    const float* X = which == 0 ? a.in[I_X] : a.out; const float* gain = a.in[which == 0 ? I_G1 : I_G2];
    f16* H = (f16*)(ws + WS_H);
    LAS float* A_ = (LAS float*)lds; LAS float* B_ = (LAS float*)(lds + 8192);
    const int sh_off = which == 0 ? 0 : 3 * DM, sc_off = sh_off + DM;
    int cur_b = -1;
    for (int rb = bid; rb < NTOK / 32; rb += nblk) {
        const int b = rb / (SEQ / 32);
        if (b != cur_b) { __syncthreads();
            for (int k = tid; k < DM; k += NT) { float sc, sh;
                if (which == 0) { sc = ada_b[sc_off + k]; sh = ada_b[sh_off + k];
#pragma unroll
                    for (int kc = 0; kc < 4; ++kc) { sc += MODP[((size_t)kc * 4 + b) * NMOD + sc_off + k]; sh += MODP[((size_t)kc * 4 + b) * NMOD + sh_off + k]; } }
                else { sc = MOD[b * NMOD + sc_off + k]; sh = MOD[b * NMOD + sh_off + k]; }
                A_[k] = gain[k] * (1.f + sc); B_[k] = sh; }
            __syncthreads(); cur_b = b; }
#pragma unroll 1
        for (int rr = 0; rr < 4; ++rr) {
            const int m = rb * 32 + wave * 4 + rr;
            const f32x4* xr = (const f32x4*)(X + (size_t)m * DM);
            f32x4 v[8]; float ss = 0.f;
#pragma unroll
            for (int j = 0; j < 8; ++j) { v[j] = xr[j * 64 + lane]; ss += v[j].x * v[j].x + v[j].y * v[j].y + v[j].z * v[j].z + v[j].w * v[j].w; }
            const float r = rsqrtf(wave_sum(ss) * (1.f / DM) + EPS);
#pragma unroll
            for (int j = 0; j < 8; ++j) { const int k = j * 256 + lane * 4; const f32x4 aa = *(LAS f32x4*)(A_ + k), bb = *(LAS f32x4*)(B_ + k);
                h4 o; o.x = (f16)(v[j].x * r * aa.x + bb.x); o.y = (f16)(v[j].y * r * aa.y + bb.y); o.z = (f16)(v[j].z * r * aa.z + bb.z); o.w = (f16)(v[j].w * r * aa.w + bb.w);
                *(h4*)(H + (size_t)m * DM + k) = o; }
        }
    }
}

__device__ __forceinline__ void post_norms(const Args& a, int bid, int nblk) {
    const int tid = threadIdx.x, lane = tid & 63, wave = __builtin_amdgcn_readfirstlane(tid >> 6);
    f16* PROJ = (f16*)(a.ws + WS_PROJ);
    const int g = lane >> 4, l16 = lane & 15;
    for (int m = bid * NWV + wave; m < NTOK; m += nblk * NWV) {
        f16* row = PROJ + (size_t)m * NP;
#pragma unroll 1
        for (int it = 0; it < 7; ++it) {
            const int v = it * 4 + g; int col; const float* gn;
            if (v < 8) { col = C_FQ + v * 128; gn = a.in[I_FQG]; }
            else if (v < 16) { col = C_FK + (v - 8) * 128; gn = a.in[I_FKG]; }
            else if (v < 24) { col = C_NQ + (v - 16) * 128; gn = a.in[I_NQG]; }
            else { const int br = 1 + ((v - 24) >> 1), kvh = (v - 24) & 1; col = C_NK + br * 256 + kvh * 128; gn = a.in[I_NKG] + br * 128; }
            h8 x = *(h8*)(row + col + l16 * 8); float f[8]; float ss = 0.f;
#pragma unroll
            for (int i = 0; i < 8; ++i) { f[i] = (float)x[i]; ss += f[i] * f[i]; }
            ss += __shfl_xor(ss, 1); ss += __shfl_xor(ss, 2); ss += __shfl_xor(ss, 4); ss += __shfl_xor(ss, 8);
            const float r = rsqrtf(ss * (1.f / 128.f) + EPS);
#pragma unroll
            for (int i = 0; i < 8; ++i) x[i] = (f16)(f[i] * r * gn[l16 * 8 + i]);
            *(h8*)(row + col + l16 * 8) = x;
        }
    }
}
__device__ __forceinline__ void post_cumsum(const Args& a, int bid, int nblk) {
    const int tid = threadIdx.x, lane = tid & 63, wave = __builtin_amdgcn_readfirstlane(tid >> 6);
    const f16* PROJ = (const f16*)(a.ws + WS_PROJ); float* CUM = (float*)(a.ws + WS_CUM);
    for (int s = bid * NWV + wave; s < NB * NFH; s += nblk * NWV) {
        const int b = s >> 3, h = s & 7; const float fb = a.in[I_FB][h];
        float v[32]; float run = 0.f;
#pragma unroll
        for (int i = 0; i < 32; ++i) { const int t = lane * 32 + i; const float x = (float)PROJ[(size_t)(b * SEQ + t) * NP + C_FF + h] + fb;
            const float ls = fminf(x, 0.f) - log1pf(__expf(-fabsf(x))); run += ls; v[i] = run; }
        float incl = run;
#pragma unroll
        for (int o = 1; o < 64; o <<= 1) { const float n = __shfl_up(incl, o); if (lane >= o) incl += n; }
        const float excl = incl - run;
#pragma unroll
        for (int i = 0; i < 32; ++i) CUM[(size_t)s * SEQ + lane * 32 + i] = v[i] + excl;
    }
}

__device__ __forceinline__ void stage_ynorm(const Args& a, int bid, int nblk) {
    const int tid = threadIdx.x, lane = tid & 63, wave = __builtin_amdgcn_readfirstlane(tid >> 6);
    unsigned char* ws = a.ws;
    const f16* OF = (const f16*)(ws + WS_OF); const f16* OC = (const f16*)(ws + WS_OC); const f16* OS = (const f16*)(ws + WS_OS); const f16* OW = (const f16*)(ws + WS_OW);
    const f16* PROJ = (const f16*)(ws + WS_PROJ); f16* Y = (f16*)(ws + WS_H); const float* mog = a.in[I_MOG];
    for (int m = bid * NWV + wave; m < NTOK; m += nblk * NWV) {
        float f[16], n[16]; float ssf = 0.f, ssn = 0.f;
        const size_t o16 = (size_t)m * 1024 + lane * 16;
        const int hd = lane >> 3;
        const f16* gp = PROJ + (size_t)m * NP + C_NG + hd * 3;
        const float g0 = sigmoid_f((float)gp[0]), g1 = sigmoid_f((float)gp[1]), g2 = sigmoid_f((float)gp[2]);
#pragma unroll
        for (int hh = 0; hh < 2; ++hh) {
            const h8 xf = *(const h8*)(OF + o16 + hh * 8), xc = *(const h8*)(OC + o16 + hh * 8), xs = *(const h8*)(OS + o16 + hh * 8), xw = *(const h8*)(OW + o16 + hh * 8);
#pragma unroll
            for (int i = 0; i < 8; ++i) { f[hh * 8 + i] = (float)xf[i]; n[hh * 8 + i] = g0 * (float)xc[i] + g1 * (float)xs[i] + g2 * (float)xw[i];
                ssf += f[hh * 8 + i] * f[hh * 8 + i]; ssn += n[hh * 8 + i] * n[hh * 8 + i]; }
        }
        const float rf = rsqrtf(wave_sum(ssf) * (1.f / 1024.f) + EPS), rn = rsqrtf(wave_sum(ssn) * (1.f / 1024.f) + EPS);
#pragma unroll
        for (int hh = 0; hh < 2; ++hh) { h8 of, on;
#pragma unroll
            for (int i = 0; i < 8; ++i) { const int k = lane * 16 + hh * 8 + i; of[i] = (f16)(f[hh * 8 + i] * rf * mog[k]); on[i] = (f16)(n[hh * 8 + i] * rn * mog[1024 + k]); }
            *(h8*)(Y + (size_t)m * DM + lane * 16 + hh * 8) = of; *(h8*)(Y + (size_t)m * DM + 1024 + lane * 16 + hh * 8) = on; }
    }
}
#if NAIVE_BUILD
template <int MODE> __global__ void __launch_bounds__(256) naive_gemm(Args a) {
    unsigned char* ws = a.ws;
    const int tx = threadIdx.x & 15, ty = threadIdx.x >> 4;
    const int n0 = blockIdx.x * 64 + tx * 4, m0 = blockIdx.y * 64 + ty * 4;
    const f16* A; const f16* Bt; int K;
    if (MODE == 0) { A = (const f16*)(ws + WS_H); Bt = (const f16*)(ws + WS_WIN); K = DM; }
    else if (MODE == 1) { A = (const f16*)(ws + WS_H); Bt = (const f16*)(ws + WS_WOUT); K = DM; }
    else if (MODE == 2) { A = (const f16*)(ws + WS_H); Bt = (const f16*)(ws + WS_WGU); K = DM; }
    else { A = (const f16*)(ws + WS_PROJ); Bt = (const f16*)(ws + WS_WDN); K = DFF; }
    int brow[4], urow[4];
#pragma unroll
    for (int j = 0; j < 4; ++j) { const int n = n0 + j;
        if (MODE == 2) { brow[j] = 256 * (n >> 7) + (n & 127); urow[j] = brow[j] + 128; } else { brow[j] = n; urow[j] = n; } }
    float acc[4][4] = {}, accu[4][4] = {};
    for (int k = 0; k < K; k += 8) {
        h8 av[4], bv[4], uv[4];
#pragma unroll
        for (int i = 0; i < 4; ++i) av[i] = *(const h8*)(A + (size_t)(m0 + i) * K + k);
#pragma unroll
        for (int j = 0; j < 4; ++j) { bv[j] = *(const h8*)(Bt + (size_t)brow[j] * K + k); if (MODE == 2) uv[j] = *(const h8*)(Bt + (size_t)urow[j] * K + k); }
#pragma unroll
        for (int e = 0; e < 8; ++e)
#pragma unroll
            for (int i = 0; i < 4; ++i)
#pragma unroll
                for (int j = 0; j < 4; ++j) { acc[i][j] += (float)av[i][e] * (float)bv[j][e]; if (MODE == 2) accu[i][j] += (float)av[i][e] * (float)uv[j][e]; }
    }
    const float* MOD = (const float*)(ws + WS_MOD);
#pragma unroll
    for (int i = 0; i < 4; ++i) { const int m = m0 + i, b = m / SEQ;
#pragma unroll
        for (int j = 0; j < 4; ++j) { const int n = n0 + j;
            if (MODE == 0) ((f16*)(ws + WS_PROJ))[(size_t)m * NP + n] = (f16)acc[i][j];
            else if (MODE == 1) a.out[(size_t)m * DM + n] = a.in[I_X][(size_t)m * DM + n] + MOD[b * NMOD + 2 * DM + n] * acc[i][j];
            else if (MODE == 2) ((f16*)(ws + WS_PROJ))[(size_t)m * DFF + n] = (f16)(silu_f(acc[i][j]) * accu[i][j]);
            else a.out[(size_t)m * DM + n] = a.out[(size_t)m * DM + n] + MOD[b * NMOD + 5 * DM + n] * acc[i][j]; } }
}

__device__ __forceinline__ void row_step(bool valid, float bias, const h8 (&q)[16], const f16* krow, const f16* vrow, float& m, float& l, float (&o)[128]) {
    float s = 0.f;
#pragma unroll
    for (int c = 0; c < 16; ++c) { const h8 kv = *(const h8*)(krow + c * 8);
#pragma unroll
        for (int e = 0; e < 8; ++e) s += (float)q[c][e] * (float)kv[e]; }
    s = s * SCALE + bias;
    if (valid) {
        const float mn = fmaxf(m, s), al = __expf(m - mn), p = __expf(s - mn);
        l = l * al + p; m = mn;
#pragma unroll
        for (int c = 0; c < 16; ++c) { const h8 vv = *(const h8*)(vrow + c * 8);
#pragma unroll
            for (int e = 0; e < 8; ++e) o[c * 8 + e] = o[c * 8 + e] * al + p * (float)vv[e]; }
    }
}
__device__ __forceinline__ void row_store(f16* dst, float l, const float (&o)[128]) {
    const float inv = l > 0.f ? 1.f / l : 0.f;
#pragma unroll
    for (int c = 0; c < 16; ++c) { h8 w;
#pragma unroll
        for (int e = 0; e < 8; ++e) w[e] = (f16)(o[c * 8 + e] * inv);
        *(h8*)(dst + c * 8) = w; }
}

__global__ void __launch_bounds__(256) naive_fox(Args a) {
    unsigned char* ws = a.ws; const f16* PROJ = (const f16*)(ws + WS_PROJ); const float* CUM = (const float*)(ws + WS_CUM);
    const int tb = blockIdx.x & 7, h = (blockIdx.x >> 3) & 7, b = blockIdx.x >> 6, t = tb * 256 + threadIdx.x;
    h8 q[16];
#pragma unroll
    for (int c = 0; c < 16; ++c) q[c] = *(const h8*)(PROJ + (size_t)(b * SEQ + t) * NP + C_FQ + h * 128 + c * 8);
    const float* cum = CUM + (size_t)(b * 8 + h) * SEQ; const float cq = cum[t];
    float m = -1e30f, l = 0.f; float o[128];
#pragma unroll
    for (int i = 0; i < 128; ++i) o[i] = 0.f;
    const int jmax = tb * 256 + 255;
    for (int j = 0; j <= jmax; ++j) {
        const f16* kr = PROJ + (size_t)(b * SEQ + j) * NP + C_FK + h * 128; const f16* vr = PROJ + (size_t)(b * SEQ + j) * NP + C_FV + h * 128;
        row_step(j <= t, cq - cum[j], q, kr, vr, m, l, o);
    }
    row_store((f16*)(ws + WS_OF) + (size_t)(b * SEQ + t) * 1024 + h * 128, l, o);
}
__global__ void __launch_bounds__(256) naive_cmp(Args a) {
    unsigned char* ws = a.ws; const f16* PROJ = (const f16*)(ws + WS_PROJ); const float* TBL = (const float*)(ws + WS_TBL);
    const int tb = blockIdx.x & 7, h = (blockIdx.x >> 3) & 7, b = blockIdx.x >> 6, t = tb * 256 + threadIdx.x, kvh = h >> 2;
    const f16* KC = (const f16*)(ws + WS_KC) + (size_t)(b * 2 + kvh) * 128 * 128; const f16* VC = (const f16*)(ws + WS_VC) + (size_t)(b * 2 + kvh) * 128 * 128;
    float* PC = (float*)(ws + WS_SCR) + ((size_t)(b * SEQ + t) * 8 + h) * 128;
    h8 q[16];
#pragma unroll
    for (int c = 0; c < 16; ++c) q[c] = *(const h8*)(PROJ + (size_t)(b * SEQ + t) * NP + C_NQ + h * 128 + c * 8);
    float m = -1e30f, l = 0.f; float o[128];
#pragma unroll
    for (int i = 0; i < 128; ++i) o[i] = 0.f;
    for (int c = 0; c < NCMP; ++c) { const int d = t - (16 * c + 31); const int dd = d < 0 ? 0 : (d > 127 ? 127 : d);
        row_step(d >= 0, TBL[h * 128 + dd], q, KC + c * 128, VC + c * 128, m, l, o); }
    row_store((f16*)(ws + WS_OC) + (size_t)(b * SEQ + t) * 1024 + h * 128, l, o);
    const float inv = l > 0.f ? 1.f / l : 0.f;
    for (int c = 0; c < 128; ++c) { const int d = t - (16 * c + 31); float p = 0.f;
        if (c < NCMP && d >= 0) { const int dd = d > 127 ? 127 : d; float s = 0.f;
#pragma unroll
            for (int cc = 0; cc < 16; ++cc) { const h8 kv = *(const h8*)(KC + c * 128 + cc * 8);
#pragma unroll
                for (int e = 0; e < 8; ++e) s += (float)q[cc][e] * (float)kv[e]; }
            p = __expf(s * SCALE + TBL[h * 128 + dd] - m) * inv; }
        PC[c] = p; }
}
__device__ __forceinline__ unsigned topk_mask(const float (&impin)[32], int t) {
    float v[32]; const int cur = t >> 6;
#pragma unroll
    for (int j = 0; j < 32; ++j) { float x = impin[j]; if (j == 0 || j == cur || j == cur - 1) x = 1e6f; if (j > cur) x = -__builtin_inff(); v[j] = x; }
    unsigned mask = 0u;
#pragma unroll 1
    for (int it = 0; it < NSEL; ++it) { float best = -__builtin_inff(); int bi = -1;
#pragma unroll
        for (int j = 0; j < 32; ++j) if (v[j] > best) { best = v[j]; bi = j; }
        if (bi < 0) break;
        mask |= 1u << bi;
#pragma unroll
        for (int j = 0; j < 32; ++j) if (j == bi) v[j] = -__builtin_inff(); }
    return mask;
}
__global__ void __launch_bounds__(256) naive_topk(Args a) {
    unsigned char* ws = a.ws;
    const int idx = blockIdx.x * 256 + threadIdx.x; if (idx >= NTOK * 2) return;
    const int tok = idx >> 1, kvh = idx & 1, t = tok & (SEQ - 1);
    const float* PC = (const float*)(ws + WS_SCR) + ((size_t)tok * 8 + kvh * 4) * 128;
    float imp[32];
#pragma unroll
    for (int j = 0; j < 32; ++j) { float s = 0.f;
#pragma unroll
        for (int hh = 0; hh < 4; ++hh) { const float* p = PC + hh * 128;
            if (j > 0) s += p[4 * j - 1];
            s += 2.f * (p[4 * j] + p[4 * j + 1] + p[4 * j + 2]); if (4 * j + 3 < NCMP) s += p[4 * j + 3]; }
        imp[j] = s; }
    ((unsigned*)(ws + WS_SEL))[idx] = topk_mask(imp, t);
}
__global__ void __launch_bounds__(256) naive_selwin(Args a) {
    unsigned char* ws = a.ws; const f16* PROJ = (const f16*)(ws + WS_PROJ); const float* TBL = (const float*)(ws + WS_TBL);
    const int tb = blockIdx.x & 7, h = (blockIdx.x >> 3) & 7, b = blockIdx.x >> 6, t = tb * 256 + threadIdx.x, kvh = h >> 2;
    h8 q[16];
#pragma unroll
    for (int c = 0; c < 16; ++c) q[c] = *(const h8*)(PROJ + (size_t)(b * SEQ + t) * NP + C_NQ + h * 128 + c * 8);
    const unsigned mask = ((const unsigned*)(ws + WS_SEL))[(size_t)(b * SEQ + t) * 2 + kvh];
    float o[128];
    {
        float m = -1e30f, l = 0.f;
#pragma unroll
        for (int i = 0; i < 128; ++i) o[i] = 0.f;
        const int jmax = (tb * 256 + 255) >> 6;
        for (int j = 0; j <= jmax; ++j) { const bool sel = (mask >> j) & 1u;
            if (!__any(sel)) continue;
            for (int i = 0; i < 64; ++i) { const int s = j * 64 + i; const int d = t - s; const int dd = d < 0 ? 0 : (d > 127 ? 127 : d);
                const f16* kr = PROJ + (size_t)(b * SEQ + s) * NP + C_NK + 256 + kvh * 128; const f16* vr = PROJ + (size_t)(b * SEQ + s) * NP + C_NV + 256 + kvh * 128;
                row_step(sel && d >= 0, TBL[h * 128 + dd], q, kr, vr, m, l, o); } }
        row_store((f16*)(ws + WS_OS) + (size_t)(b * SEQ + t) * 1024 + h * 128, l, o);
    }
    {
        float m = -1e30f, l = 0.f;
#pragma unroll
        for (int i = 0; i < 128; ++i) o[i] = 0.f;
        int s0 = tb * 256 - (WIN - 1); if (s0 < 0) s0 = 0; const int s1 = tb * 256 + 255;
        for (int s = s0; s <= s1; ++s) { const int d = t - s; const int dd = d < 0 ? 0 : (d > 127 ? 127 : d);
            const f16* kr = PROJ + (size_t)(b * SEQ + s) * NP + C_NK + 512 + kvh * 128; const f16* vr = PROJ + (size_t)(b * SEQ + s) * NP + C_NV + 512 + kvh * 128;
            row_step(d >= 0 && d < WIN, TBL[h * 128 + dd], q, kr, vr, m, l, o); }
        row_store((f16*)(ws + WS_OW) + (size_t)(b * SEQ + t) * 1024 + h * 128, l, o);
    }
}
__global__ void __launch_bounds__(128) naive_compress(Args a) {
    unsigned char* ws = a.ws; const f16* PROJ = (const f16*)(ws + WS_PROJ);
    __shared__ float hid[128]; __shared__ float red[2];
    const int c = blockIdx.x & 127, kvh = (blockIdx.x >> 7) & 1, b = (blockIdx.x >> 8) & 3, wh = blockIdx.x >> 10, n = threadIdx.x;
    f16* dst = (f16*)(ws + (wh == 0 ? WS_KC : WS_VC)) + ((size_t)(b * 2 + kvh) * 128 + c) * 128;
    if (c >= NCMP) { dst[n] = (f16)0.f; return; }
    const float* w1 = a.in[I_W1] + (size_t)wh * 4096 * 128; const float* w2 = a.in[I_W2] + (size_t)wh * 128 * 128; const float* pos = a.in[I_POS] + wh * 4096;
    const int col = (wh == 0 ? C_NK : C_NV) + kvh * 128;
    float s = 0.f;
    for (int l = 0; l < 32; ++l) { const f16* xr = PROJ + (size_t)(b * SEQ + 16 * c + l) * NP + col;
        for (int d = 0; d < 128; ++d) s += ((float)xr[d] + pos[l * 128 + d]) * w1[(size_t)(l * 128 + d) * 128 + n]; }
    hid[n] = silu_f(s); __syncthreads();
    float o = 0.f;
    for (int k = 0; k < 128; ++k) o += hid[k] * w2[k * 128 + n];
    if (wh == 0) { float ss = wave_sum(o * o); if ((n & 63) == 0) red[n >> 6] = ss; __syncthreads(); ss = red[0] + red[1];
        o = o * rsqrtf(ss * (1.f / 128.f) + EPS) * a.in[I_NKG][n]; }
    dst[n] = (f16)o;
}
#endif
namespace pg8 {
#define PG8_LAS __attribute__((address_space(3)))
typedef _Float16 bf16_t;
typedef _Float16 bf16x8 __attribute__((ext_vector_type(8)));
typedef float f32x4 __attribute__((ext_vector_type(4)));
typedef unsigned u32x4 __attribute__((ext_vector_type(4)));
constexpr int BM = 256, BK = 64, HALF = 128, HTB = HALF * BK * 2  , STAGE_BYTES = 8 * HTB, NXCD = 8, WGM = 8;

__host__ __device__ __forceinline__ int lds_byte(int r, int c) { const int st = (r >> 4) * 2 + (c >> 5), rr = r & 15, cc = c & 31, ob = rr * 64 + cc * 2; return st * 1024 + (ob ^ (((ob >> 9) & 1) << 5)); }
__host__ __device__ __forceinline__ void stage_rc(int b, int& R, int& C) { const int st = b / 1024, sb = b % 1024, swz = sb ^ (((sb >> 9) & 1) << 5); R = (st >> 1) * 16 + swz / 64; C = (st & 1) * 32 + (swz % 64) / 2; }
__host__ __device__ __forceinline__ int perm32(int rho) { const int n = rho >> 4, i = rho & 15; return 8 * (i >> 2) + 4 * n + (i & 3); }

struct Unit { int pm, pn; };
struct Gemm { const bf16_t* A; const bf16_t* Bt; int M, N, K; };

struct StaticOrder {
    int nM, nN, nwg, G, c;
    __host__ __device__ void init(int M, int N, int G_, int c_) { nM = M / BM; nN = N / BM; nwg = nM * nN; G = G_; c = c_; }
    __host__ __device__ bool next(int i, Unit& u) const {
        const long L = (long)i * G + c; if (L >= nwg) return false;
        int wgid = (int)L; { const int q = nwg / NXCD, r = nwg % NXCD, xcd = wgid % NXCD, off = wgid / NXCD; wgid = (xcd < r ? xcd * (q + 1) : r * (q + 1) + (xcd - r) * q) + off; }
        const int nig = WGM * nN, gid = wgid / nig, fm = gid * WGM, gsz = (nM - fm) < WGM ? (nM - fm) : WGM;
        u.pm = fm + ((wgid % nig) % gsz); u.pn = (wgid % nig) / gsz; return true;
    }
    __device__ __forceinline__ void a_ready(const Unit&) const {}
    __device__ __forceinline__ void done(const Unit&) const {}
};

template <class Epi, class Sched, bool ALIGN_EPI = false, bool SP2 = false>
__device__ __forceinline__ void gemm_phase(PG8_LAS unsigned char* lds, const Gemm g, const Sched& S, const Epi& E) {
    const int tid = threadIdx.x, wid = __builtin_amdgcn_readfirstlane(tid >> 6), lane = tid & 63, wr = wid >> 2, wc = wid & 3, fr = lane & 15, fq = lane >> 4;
    const int K = g.K, nt = K / BK;
    unsigned voffA[2], voffB[2];
#pragma unroll
    for (int i = 0; i < 2; ++i) { int R, C; stage_rc(tid * 16 + i * 8192, R, C); const int Rb = Epi::PERM ? ((R & ~31) + perm32(R & 31)) : R;
        voffA[i] = (unsigned)(R * K + C) * 2u; voffB[i] = (unsigned)(Rb * K + C) * 2u; }
    const size_t kstep = (size_t)(BK * 2);
    const size_t hstep = (size_t)HALF * K * 2;
    const size_t tstep = 2 * hstep;
    const unsigned ldsw = (unsigned)wid * 1024u;
    const int aoff = lds_byte(wr * 64 + fr, fq * 8), boff = lds_byte(wc * 32 + fr, fq * 8);
#define PG8_SA(b, h) (((b) * 2 + (h)) * HTB)
#define PG8_SB(b, h) ((4 + (b) * 2 + (h)) * HTB)
#define PG8_STAGE(bufoff, gbase, voff) do { _Pragma("unroll") for (int _i = 0; _i < 2; ++_i) \
        __builtin_amdgcn_global_load_lds((const unsigned*)((const char*)(gbase) + (voff)[_i]), (PG8_LAS unsigned*)(lds + (bufoff) + ldsw + _i * 8192), 16, 0, 0); } while (0)
#define PG8_LDA(dst, b, h) do { _Pragma("unroll") for (int m = 0; m < 4; ++m) _Pragma("unroll") for (int k = 0; k < 2; ++k) dst[m][k] = *(const PG8_LAS bf16x8*)(lds + PG8_SA(b, h) + aoff + m * 2048 + k * 1024); } while (0)
#define PG8_LDB(dst, b, h) do { _Pragma("unroll") for (int n = 0; n < 2; ++n) _Pragma("unroll") for (int k = 0; k < 2; ++k) dst[n][k] = *(const PG8_LAS bf16x8*)(lds + PG8_SB(b, h) + boff + n * 2048 + k * 1024); } while (0)
#define PG8_MMA(ai, bj, At, Bt) do { __builtin_amdgcn_s_setprio(1); _Pragma("unroll") for (int m = 0; m < 4; ++m) _Pragma("unroll") for (int n = 0; n < 2; ++n) _Pragma("unroll") for (int k = 0; k < 2; ++k) \
        acc[ai][bj][m][n] = __builtin_amdgcn_mfma_f32_16x16x32_f16(Bt[n][k], At[m][k], acc[ai][bj][m][n], 0, 0, 0); __builtin_amdgcn_s_setprio(0); } while (0)
#define PG8_WAIT_V(n) asm volatile("s_waitcnt vmcnt(" #n ")" ::: "memory")
#define PG8_WAIT_L(n) asm volatile("s_waitcnt lgkmcnt(" #n ")" ::: "memory")
#define PG8_BAR __builtin_amdgcn_s_barrier()
#define PG8_SCHED __builtin_amdgcn_sched_barrier(0)
    Unit cur, nxt; int ui = 0;
    if (!S.next(0, cur)) return;
    f32x4 acc[2][2][4][2];
#pragma unroll
    for (int a = 0; a < 2; ++a)
#pragma unroll
        for (int b = 0; b < 2; ++b)
#pragma unroll
            for (int m = 0; m < 4; ++m)
#pragma unroll
                for (int n = 0; n < 2; ++n) acc[a][b][m][n] = (f32x4){0.f, 0.f, 0.f, 0.f};
    bf16x8 At[4][2], B0[2][2], B1[2][2];
    const char* cA = (const char*)g.A + (size_t)cur.pm * tstep; const char* cB = (const char*)g.Bt + (size_t)cur.pn * tstep;
    S.a_ready(cur);
    if constexpr (SP2) {
        PG8_STAGE(PG8_SB(0, 0), cB, voffB); PG8_STAGE(PG8_SB(0, 1), cB + hstep, voffB); PG8_STAGE(PG8_SA(0, 0), cA, voffA); PG8_STAGE(PG8_SA(0, 1), cA + hstep, voffA);
        if (wr == 1) PG8_BAR;
        PG8_WAIT_V(2); PG8_BAR;
        PG8_STAGE(PG8_SB(1, 0), cB + kstep, voffB); PG8_STAGE(PG8_SA(1, 0), cA + kstep, voffA); PG8_STAGE(PG8_SB(1, 1), cB + hstep + kstep, voffB);
        PG8_WAIT_V(6); PG8_BAR;
    } else {
        PG8_STAGE(PG8_SB(0, 0), cB, voffB); PG8_STAGE(PG8_SA(0, 0), cA, voffA); PG8_STAGE(PG8_SB(0, 1), cB + hstep, voffB); PG8_STAGE(PG8_SA(0, 1), cA + hstep, voffA);
        if (wr == 1) PG8_BAR;
        PG8_WAIT_V(4); PG8_BAR;
        PG8_STAGE(PG8_SB(1, 0), cB + kstep, voffB); PG8_STAGE(PG8_SA(1, 0), cA + kstep, voffA); PG8_STAGE(PG8_SB(1, 1), cB + hstep + kstep, voffB);
        PG8_WAIT_V(6); PG8_BAR;
    }
    for (;;) {
        const bool has_next = S.next(ui + 1, nxt);
        const char* nA = has_next ? (const char*)g.A + (size_t)nxt.pm * tstep : cA; const char* nB = has_next ? (const char*)g.Bt + (size_t)nxt.pn * tstep : cB;
        for (int t = 0; t < nt; t += 2) {
            const bool last = (t == nt - 2);
            const char* a1 = cA + (size_t)(t + 1) * kstep;
            const char* a2 = last ? nA : cA + (size_t)(t + 2) * kstep; const char* b2 = last ? nB : cB + (size_t)(t + 2) * kstep;
            const char* a3 = a2 + kstep; const char* b3 = b2 + kstep;
            if (last && has_next) S.a_ready(nxt);
            if constexpr (SP2) {
            PG8_LDB(B0, 0, 0); PG8_LDB(B1, 0, 1); PG8_SCHED; PG8_LDA(At, 0, 0); PG8_STAGE(PG8_SA(1, 1), a1 + hstep, voffA);
            PG8_WAIT_V(8); PG8_WAIT_L(0); PG8_BAR; PG8_MMA(0, 0, At, B0); PG8_MMA(0, 1, At, B1); PG8_BAR; PG8_SCHED;
            PG8_LDA(At, 0, 1); PG8_STAGE(PG8_SB(0, 0), b2, voffB); PG8_STAGE(PG8_SB(0, 1), b2 + hstep, voffB); PG8_STAGE(PG8_SA(0, 0), a2, voffA);
            PG8_WAIT_V(8); PG8_WAIT_L(0); PG8_BAR; PG8_MMA(1, 0, At, B0); PG8_MMA(1, 1, At, B1); PG8_BAR; PG8_SCHED;
            PG8_LDB(B0, 1, 0); PG8_LDB(B1, 1, 1); PG8_SCHED; PG8_LDA(At, 1, 0); PG8_STAGE(PG8_SA(0, 1), a2 + hstep, voffA);
            PG8_WAIT_V(8); PG8_WAIT_L(0); PG8_BAR; PG8_MMA(0, 0, At, B0); PG8_MMA(0, 1, At, B1); PG8_BAR; PG8_SCHED;
            PG8_LDA(At, 1, 1); PG8_STAGE(PG8_SB(1, 0), b3, voffB); PG8_STAGE(PG8_SB(1, 1), b3 + hstep, voffB); PG8_STAGE(PG8_SA(1, 0), a3, voffA);
            PG8_WAIT_V(8); PG8_WAIT_L(0); PG8_BAR; PG8_MMA(1, 0, At, B0); PG8_MMA(1, 1, At, B1); PG8_BAR; PG8_SCHED;
            } else {
            PG8_LDB(B0, 0, 0); PG8_SCHED; PG8_LDA(At, 0, 0); PG8_STAGE(PG8_SA(1, 1), a1 + hstep, voffA);
            PG8_WAIT_L(8); PG8_BAR; PG8_WAIT_L(0); PG8_MMA(0, 0, At, B0); PG8_BAR; PG8_SCHED;
            PG8_LDB(B1, 0, 1); PG8_STAGE(PG8_SB(0, 0), b2, voffB);
            PG8_BAR; PG8_WAIT_L(0); PG8_MMA(0, 1, At, B1); PG8_BAR;
            PG8_LDA(At, 0, 1); PG8_STAGE(PG8_SA(0, 0), a2, voffA);
            PG8_BAR; PG8_WAIT_L(0); PG8_MMA(1, 0, At, B0); PG8_BAR; PG8_SCHED;
            PG8_STAGE(PG8_SB(0, 1), b2 + hstep, voffB);
            PG8_WAIT_V(6); PG8_BAR; PG8_MMA(1, 1, At, B1); PG8_BAR;
            PG8_LDB(B0, 1, 0); PG8_SCHED; PG8_LDA(At, 1, 0); PG8_STAGE(PG8_SA(0, 1), a2 + hstep, voffA);
            PG8_WAIT_L(8); PG8_BAR; PG8_WAIT_L(0); PG8_MMA(0, 0, At, B0); PG8_BAR; PG8_SCHED;
            PG8_LDB(B1, 1, 1); PG8_STAGE(PG8_SB(1, 0), b3, voffB);
            PG8_BAR; PG8_WAIT_L(0); PG8_MMA(0, 1, At, B1); PG8_BAR;
            PG8_LDA(At, 1, 1); PG8_STAGE(PG8_SA(1, 0), a3, voffA);
            PG8_BAR; PG8_WAIT_L(0); PG8_MMA(1, 0, At, B0); PG8_BAR; PG8_SCHED;
            PG8_STAGE(PG8_SB(1, 1), b3 + hstep, voffB);
            PG8_WAIT_V(6); PG8_BAR; PG8_MMA(1, 1, At, B1); PG8_BAR;
            }
        }
        if constexpr (ALIGN_EPI) { if (wr == 0) PG8_BAR; }
        if constexpr (!Epi::AFTER_DRAIN) { E(acc, cur, wr, wc, fr, fq); S.done(cur); }
        if (!has_next) break;
#pragma unroll
        for (int a = 0; a < 2; ++a)
#pragma unroll
            for (int b = 0; b < 2; ++b)
#pragma unroll
                for (int m = 0; m < 4; ++m)
#pragma unroll
                    for (int n = 0; n < 2; ++n) acc[a][b][m][n] = (f32x4){0.f, 0.f, 0.f, 0.f};
        cur = nxt; cA = nA; cB = nB; ++ui;
        if constexpr (ALIGN_EPI) { if (wr == 1) PG8_BAR; }
    }
    PG8_WAIT_V(0);
    if constexpr (!ALIGN_EPI) { if (wr == 0) PG8_BAR; }
    PG8_BAR;
    if constexpr (Epi::AFTER_DRAIN) { E.fused(acc, cur, wr, wc, fr, fq, lds, wid, lane); S.done(cur); }
#undef PG8_SA
#undef PG8_SB
#undef PG8_STAGE
#undef PG8_LDA
#undef PG8_LDB
#undef PG8_MMA
#undef PG8_WAIT_V
#undef PG8_WAIT_L
#undef PG8_BAR
#undef PG8_SCHED
}
}
namespace pg8 {
struct EpiProj {
    static constexpr bool PERM = true, AFTER_DRAIN = false;
    f16* O; int ldc;
    __device__ __forceinline__ void operator()(const f32x4 (&acc)[2][2][4][2], const Unit& u, int wr, int wc, int fr, int fq) const {
        const int row0 = u.pm * BM + wr * 64 + fr, col0 = u.pn * BM + wc * 32 + 8 * fq;
#pragma unroll
        for (int ai = 0; ai < 2; ++ai)
#pragma unroll
            for (int m = 0; m < 4; ++m) { f16* rowp = O + (size_t)(row0 + ai * HALF + m * 16) * ldc + col0;
#pragma unroll
                for (int bj = 0; bj < 2; ++bj) { const f32x4 v0 = acc[ai][bj][m][0], v1 = acc[ai][bj][m][1];
                    h8 w; w[0] = (f16)v0[0]; w[1] = (f16)v0[1]; w[2] = (f16)v0[2]; w[3] = (f16)v0[3]; w[4] = (f16)v1[0]; w[5] = (f16)v1[1]; w[6] = (f16)v1[2]; w[7] = (f16)v1[3];
                    *(h8*)(rowp + bj * HALF) = w; } }
    }
};
struct EpiGU {
    static constexpr bool PERM = true, AFTER_DRAIN = false;
    f16* O;
    __device__ __forceinline__ void operator()(const f32x4 (&acc)[2][2][4][2], const Unit& u, int wr, int wc, int fr, int fq) const {
        const int row0 = u.pm * BM + wr * 64 + fr, col0 = u.pn * HALF + wc * 32 + 8 * fq;
#pragma unroll
        for (int ai = 0; ai < 2; ++ai)
#pragma unroll
            for (int m = 0; m < 4; ++m) { h8 w;
#pragma unroll
                for (int n = 0; n < 2; ++n)
#pragma unroll
                    for (int e = 0; e < 4; ++e) { const float g = acc[ai][0][m][n][e], up = acc[ai][1][m][n][e];
                        w[n * 4 + e] = (f16)(g * __builtin_amdgcn_rcpf(1.f + __expf(-g)) * up); }
                *(h8*)(O + (size_t)(row0 + ai * HALF + m * 16) * DFF + col0) = w; }
    }
};
struct EpiRes {
    static constexpr bool PERM = false, AFTER_DRAIN = false;
    const float* base; float* out; const float* gate;
    __device__ __forceinline__ void operator()(const f32x4 (&acc)[2][2][4][2], const Unit& u, int wr, int wc, int fr, int fq) const {
        const int row0 = u.pm * BM + wr * 64 + fr, col0 = u.pn * BM + wc * 32 + 4 * fq;
        const float* gp = gate + (size_t)((u.pm * BM) / SEQ) * NMOD + col0;
        f32x4 gv[2][2];
#pragma unroll
        for (int bj = 0; bj < 2; ++bj)
#pragma unroll
            for (int n = 0; n < 2; ++n) gv[bj][n] = *(const f32x4*)(gp + bj * HALF + n * 16);
#pragma unroll
        for (int ai = 0; ai < 2; ++ai)
#pragma unroll
            for (int m = 0; m < 4; ++m) { const size_t off = (size_t)(row0 + ai * HALF + m * 16) * DM + col0;
#pragma unroll
                for (int bj = 0; bj < 2; ++bj)
#pragma unroll
                    for (int n = 0; n < 2; ++n) { const f32x4 bs = *(const f32x4*)(base + off + bj * HALF + n * 16);
                        *(f32x4*)(out + off + bj * HALF + n * 16) = bs + gv[bj][n] * acc[ai][bj][m][n]; } }
    }
};
}
#ifndef PG8_SP2
#define PG8_SP2 true
#endif
#ifndef PG8_ALIGN
#define PG8_ALIGN true
#endif
#define XB_TMO      128
#define XB_XCNT(j)  (256  + 64 * (j))
#define XB_XSUB(j)  (1280 + 64 * (j))
#define XB_XGEN(j)  (2304 + 64 * (j))
#define XB_TOP      3328
#define XB_TOPGEN   3392
#define XCD_BAR_WORDS 3456
#define XB_SPIN_CAP (1u << 18)

__device__ __forceinline__ unsigned xb_ld(unsigned* p)              { return __hip_atomic_load(p, __ATOMIC_RELAXED, __HIP_MEMORY_SCOPE_AGENT); }
__device__ __forceinline__ unsigned xb_add(unsigned* p, unsigned v) { return __hip_atomic_fetch_add(p, v, __ATOMIC_RELAXED, __HIP_MEMORY_SCOPE_AGENT); }
__device__ __forceinline__ unsigned xb_xcc_id() { return (unsigned)__builtin_amdgcn_s_getreg((3 << 11) | 20) & 0xFu; }
#define XB_SPIN(cond, bar) do { unsigned _sp = 0; while (cond) { __builtin_amdgcn_s_sleep(1); \
    if ((++_sp & 255u) == 0u) { if (xb_ld(&(bar)[XB_TMO])) break; if (_sp > XB_SPIN_CAP) { atomicAdd(&(bar)[XB_TMO], 1u); break; } } } } while (0)

struct XcdBarrier {
    unsigned* bar; unsigned x;
    volatile LAS unsigned* st;
};

__device__ __forceinline__ XcdBarrier xcd_barrier_post(unsigned* bar, volatile LAS unsigned* st) {
    XcdBarrier b; b.bar = bar; b.x = xb_xcc_id(); b.st = st;
    if (threadIdx.x == 0) (void)xb_add(&bar[XB_XCNT(b.x)], 1u);
    return b;
}
__device__ __forceinline__ void xcd_barrier_complete(unsigned* bar, unsigned x, unsigned& nloc, unsigned& nx) {
    const unsigned G = gridDim.x * gridDim.y * gridDim.z;
    unsigned sum, cnt, mine, sp = 0u;
    for (;;) {
        sum = 0u; cnt = 0u; mine = 0u;
#pragma unroll
        for (unsigned j = 0; j < 16; ++j) { const unsigned c = xb_ld(&bar[XB_XCNT(j)]); sum += c; cnt += (c > 0u) ? 1u : 0u; mine = (j == x) ? c : mine; }
        if (sum == G) break;
        __builtin_amdgcn_s_sleep(1);
        if ((++sp & 255u) == 0u) { if (xb_ld(&bar[XB_TMO])) break; if (sp > XB_SPIN_CAP) { atomicAdd(&bar[XB_TMO], 1u); break; } }
    }
    nloc = mine > 0u ? mine : 1u; nx = cnt > 0u ? cnt : 1u;
}

__device__ __forceinline__ void xcd_barrier(const XcdBarrier& b) {
    asm volatile("s_waitcnt vmcnt(0)" ::: "memory");
    __syncthreads();
    if (threadIdx.x == 0) {
        unsigned* bar = b.bar;
        __builtin_amdgcn_s_waitcnt(0);
        unsigned nloc = b.st[0], nx = b.st[1];
        if (nloc == 0u) { xcd_barrier_complete(bar, b.x, nloc, nx); b.st[0] = nloc; b.st[1] = nx; }
        const unsigned old = xb_add(&bar[XB_XSUB(b.x)], 1u);
        const unsigned gen = old / nloc;
        if (old + 1u == (gen + 1u) * nloc) {
            __builtin_amdgcn_fence(__ATOMIC_RELEASE, "agent");
            asm volatile("s_waitcnt vmcnt(0)" ::: "memory");
            const unsigned og = xb_add(&bar[XB_TOP], 1u);
            const unsigned tg = og / nx;
            if (og + 1u == (tg + 1u) * nx) xb_add(&bar[XB_TOPGEN], 1u);
            else XB_SPIN(xb_ld(&bar[XB_TOPGEN]) == tg, bar);
            __builtin_amdgcn_fence(__ATOMIC_ACQUIRE, "agent");
            xb_add(&bar[XB_XGEN(b.x)], 1u);
            asm volatile("s_waitcnt vmcnt(0)" ::: "memory");
        } else {
            XB_SPIN(xb_ld(&bar[XB_XGEN(b.x)]) == gen, bar);
            __builtin_amdgcn_fence(__ATOMIC_ACQUIRE, "agent");
            asm volatile("s_waitcnt vmcnt(0)" ::: "memory");
        }
    }
    __syncthreads();
}
__device__ __forceinline__ void compress_task(const Args& a, char* lds, int task) {
    const int tid = threadIdx.x, wid = __builtin_amdgcn_readfirstlane(tid >> 6), lane = tid & 63, l15 = lane & 15, lq = lane >> 4;
    unsigned char* ws = a.ws;
    const int ct = task & 7, kvh = (task >> 3) & 1, b = (task >> 4) & 3, wh = task >> 6;
    const f16* PROJ = (const f16*)(ws + WS_PROJ);
    const f16* W1T = (const f16*)(ws + WS_W1T) + (size_t)wh * 128 * 4096; const f16* W2T = (const f16*)(ws + WS_W2T) + (size_t)wh * 128 * 128;
    const float* B1 = (const float*)(ws + WS_B1) + wh * 128;
    const int col = (wh == 0 ? C_NK : C_NV) + kvh * 128;
    const int c = ct * 16 + l15;
    const f16* wrow = W1T + (size_t)(wid * 16 + l15) * 4096 + lq * 8;
    f32x4 acc = {0.f, 0.f, 0.f, 0.f};
#pragma unroll 8
    for (int ks = 0; ks < 128; ++ks) {
        int tok = 16 * c + (ks >> 2); tok = tok > SEQ - 1 ? SEQ - 1 : tok;
        const h8 av = *(const h8*)(PROJ + (size_t)(b * SEQ + tok) * NP + col + (ks & 3) * 32 + lq * 8);
        const h8 bv = *(const h8*)(wrow + ks * 32);
        acc = __builtin_amdgcn_mfma_f32_16x16x32_f16(av, bv, acc, 0, 0, 0);
    }
    f16* hid = (f16*)lds;
    float* ssq = (float*)(lds + 4096);
    { const float bb = B1[wid * 16 + l15];
#pragma unroll
      for (int i = 0; i < 4; ++i) hid[(4 * lq + i) * 128 + wid * 16 + l15] = (f16)silu_f(acc[i] + bb); }
    __syncthreads();
    f32x4 acc2 = {0.f, 0.f, 0.f, 0.f};
#pragma unroll
    for (int s = 0; s < 4; ++s) {
        const h8 av = *(const h8*)(hid + l15 * 128 + s * 32 + lq * 8);
        const h8 bv = *(const h8*)(W2T + (size_t)(wid * 16 + l15) * 128 + s * 32 + lq * 8);
        acc2 = __builtin_amdgcn_mfma_f32_16x16x32_f16(av, bv, acc2, 0, 0, 0);
    }
    float rs[4] = {1.f, 1.f, 1.f, 1.f};
    if (wh == 0) {
#pragma unroll
        for (int i = 0; i < 4; ++i) { float s = acc2[i] * acc2[i]; s += __shfl_xor(s, 1); s += __shfl_xor(s, 2); s += __shfl_xor(s, 4); s += __shfl_xor(s, 8);
            if (l15 == 0) ssq[wid * 16 + 4 * lq + i] = s; }
    }
    __syncthreads();
    if (wh == 0) {
        const float gn = a.in[I_NKG][wid * 16 + l15];
#pragma unroll
        for (int i = 0; i < 4; ++i) { float s = 0.f;
#pragma unroll
            for (int w = 0; w < 8; ++w) s += ssq[w * 16 + 4 * lq + i];
            rs[i] = rsqrtf(s * (1.f / 128.f) + EPS) * gn; }
    }
    f16* dst = (f16*)(ws + (wh == 0 ? WS_KC : WS_VC)) + (size_t)(b * 2 + kvh) * 128 * 128;
#pragma unroll
    for (int i = 0; i < 4; ++i) { const int cr = ct * 16 + 4 * lq + i; dst[(size_t)cr * 128 + wid * 16 + l15] = cr < NCMP ? (f16)(acc2[i] * rs[i]) : (f16)0.f; }
    __syncthreads();
}
namespace att {
constexpr int KVBLK = 64, SHM_K = 16384, SHM_V = 16384;
constexpr int L_V = 0, L_K = 32768, L_WSF = 65536, L_KB = 67584, L_TBL = 68096, L_SELM = 72192, L_UNION = 72448, L_TL = 72512, L_IMPH = 73728, L_END = 107520;
constexpr float C2 = LOG2E * SCALE, THR2 = 8.f * LOG2E;
#define KSWZ(row, colB) ((row) * 256 + ((colB) ^ (((row) & 7) << 4)))
#define SBAR() __builtin_amdgcn_sched_barrier(0)
__device__ __forceinline__ int v_st(int k, int c) { const int kk = (k & ~0xC) | ((k & 4) << 1) | ((k & 8) >> 1); return ((kk >> 3) * 4 + (c >> 5)) * 512 + ((kk & 7) * 32 + (c & 31)) * 2; }
__device__ __forceinline__ int v_rd_base(int lane) { return ((lane & 3) << 3) | (((lane >> 2) & 3) << 6) | (((lane >> 4) & 1) << 5) | (((lane >> 5) & 1) << 8); }
constexpr int v_rd_off(int d0, int ks, int half) { return d0 * 512 + ks * 4096 + half * 2048; }
__device__ __forceinline__ int crow(int r, int hi) { return (r & 3) + 8 * (r >> 2) + 4 * hi; }
__device__ __forceinline__ unsigned cvtpk(float lo, float hi) { h2 v; v.x = (f16)lo; v.y = (f16)hi; return __builtin_bit_cast(unsigned, v); }
typedef short s16x4 __attribute__((ext_vector_type(4)));

__device__ __forceinline__ void qkt(f32x16& p0, f32x16& p1, const char* K_lds, int r32, int hi, const h8* qr) {
    p0 = f32x16{}; p1 = f32x16{};
    const char* kb[4];
#pragma unroll
    for (int dd = 0; dd < 4; ++dd) kb[dd] = K_lds + KSWZ(r32, (dd * 16 + hi * 8) * 2);
#pragma unroll
    for (int d0 = 0; d0 < 8; ++d0) { const char* a = kb[d0 & 3] + (d0 >> 2) * 128;
        const h8 b0 = *reinterpret_cast<const h8*>(a);
        const h8 b1 = *reinterpret_cast<const h8*>(a + 32 * 256);
        p0 = __builtin_amdgcn_mfma_f32_32x32x16_f16(b0, qr[d0], p0, 0, 0, 0);
        p1 = __builtin_amdgcn_mfma_f32_32x32x16_f16(b1, qr[d0], p1, 0, 0, 0);
        if (d0 == 3) SBAR(); }
}
__device__ __forceinline__ void pv_tile(f32x16* o, int vb0, h8 pa0, h8 pa1, h8 pa2, h8 pa3) {
#define TRRD(dst, off) asm volatile("ds_read_b64_tr_b16 %0, %1 offset:%2" : "=&v"(dst) : "v"(vb0), "i"(off) : "memory")
#define PV_D0(d0) do { s16x4 l0, l1, l2, l3, g0, g1, g2, g3; constexpr int b_ = v_rd_off(d0, 0, 0); \
        TRRD(l0, b_); TRRD(g0, b_ + 2048); TRRD(l1, b_ + 4096); TRRD(g1, b_ + 6144); TRRD(l2, b_ + 8192); TRRD(g2, b_ + 10240); TRRD(l3, b_ + 12288); TRRD(g3, b_ + 14336); \
        asm volatile("s_waitcnt lgkmcnt(0)" ::: "memory"); SBAR(); \
        o[d0] = __builtin_amdgcn_mfma_f32_32x32x16_f16(pa0, __builtin_bit_cast(h8, (short __attribute__((ext_vector_type(8)))){l0[0], l0[1], l0[2], l0[3], g0[0], g0[1], g0[2], g0[3]}), o[d0], 0, 0, 0); \
        o[d0] = __builtin_amdgcn_mfma_f32_32x32x16_f16(pa1, __builtin_bit_cast(h8, (short __attribute__((ext_vector_type(8)))){l1[0], l1[1], l1[2], l1[3], g1[0], g1[1], g1[2], g1[3]}), o[d0], 0, 0, 0); \
        o[d0] = __builtin_amdgcn_mfma_f32_32x32x16_f16(pa2, __builtin_bit_cast(h8, (short __attribute__((ext_vector_type(8)))){l2[0], l2[1], l2[2], l2[3], g2[0], g2[1], g2[2], g2[3]}), o[d0], 0, 0, 0); \
        o[d0] = __builtin_amdgcn_mfma_f32_32x32x16_f16(pa3, __builtin_bit_cast(h8, (short __attribute__((ext_vector_type(8)))){l3[0], l3[1], l3[2], l3[3], g3[0], g3[1], g3[2], g3[3]}), o[d0], 0, 0, 0); } while (0)
    PV_D0(0); PV_D0(1); PV_D0(2); PV_D0(3);
#undef PV_D0
#undef TRRD
}
__device__ __forceinline__ void partialSM(f32x16& p0, f32x16& p1, float& m_reg, float& mn, float& alpha) {
    float pmax = p0[0];
#pragma unroll
    for (int r = 1; r < 16; ++r) pmax = fmaxf(pmax, p0[r]);
#pragma unroll
    for (int r = 0; r < 16; ++r) pmax = fmaxf(pmax, p1[r]);
    { auto rr = __builtin_amdgcn_permlane32_swap(__float_as_uint(pmax), __float_as_uint(pmax), false, false);
      pmax = fmaxf(__uint_as_float(rr[0]), __uint_as_float(rr[1])); }
    if (__builtin_expect(__all((pmax - m_reg) <= THR2), 1)) { mn = m_reg; alpha = 1.f; }
    else { mn = fmaxf(m_reg, pmax); alpha = __builtin_amdgcn_exp2f(m_reg - mn); m_reg = mn; }
#pragma unroll
    for (int r = 0; r < 16; ++r) p0[r] = __builtin_amdgcn_exp2f(p0[r] - mn);
}
__device__ __forceinline__ void finishSM(f32x16& p0, f32x16& p1, float mn, float alpha, float& l_reg, h8& pa0, h8& pa1, h8& pa2, h8& pa3) {
#pragma unroll
    for (int r = 0; r < 16; ++r) p1[r] = __builtin_amdgcn_exp2f(p1[r] - mn);
    float ps = 0;
#pragma unroll
    for (int r = 0; r < 16; ++r) ps += p0[r];
#pragma unroll
    for (int r = 0; r < 16; ++r) ps += p1[r];
    { auto rr = __builtin_amdgcn_permlane32_swap(__float_as_uint(ps), __float_as_uint(ps), false, false);
      ps = __uint_as_float(rr[0]) + __uint_as_float(rr[1]); }
    l_reg = l_reg * alpha + ps;
#define PK4(P, B_, OUT) do { unsigned a0 = cvtpk(P[B_+0], P[B_+1]), a1 = cvtpk(P[B_+2], P[B_+3]); \
        unsigned b0 = cvtpk(P[B_+4], P[B_+5]), b1 = cvtpk(P[B_+6], P[B_+7]); \
        auto r0 = __builtin_amdgcn_permlane32_swap(a0, b0, false, false); auto r1 = __builtin_amdgcn_permlane32_swap(a1, b1, false, false); \
        u32x4 w = {r0[0], r1[0], r0[1], r1[1]}; OUT = __builtin_bit_cast(h8, w); } while (0)
    PK4(p0, 0, pa0); PK4(p0, 8, pa1); PK4(p1, 0, pa2); PK4(p1, 8, pa3);
#undef PK4
}
__device__ __forceinline__ void mask_tile(f32x16& p0, f32x16& p1, int dq, unsigned W) {
    const float NEG = -__builtin_inff();
#pragma unroll
    for (int r = 0; r < 16; ++r) { const int c = (r & 3) + 8 * (r >> 2);
        if ((unsigned)(dq - c) >= W) p0[r] = NEG;
        if ((unsigned)(dq - c - 32) >= W) p1[r] = NEG; }
}
__device__ __forceinline__ void t5_bias(f32x16& p0, f32x16& p1, int dq, const float* tb) {
#pragma unroll
    for (int r = 0; r < 16; ++r) { const int c = (r & 3) + 8 * (r >> 2);
        int d0 = dq - c, d1 = dq - c - 32;
        d0 = d0 < 0 ? 0 : (d0 > 127 ? 127 : d0); d1 = d1 < 0 ? 0 : (d1 > 127 ? 127 : d1);
        p0[r] += tb[d0]; p1[r] += tb[d1];
        if ((r & 3) == 3) SBAR(); }
}

enum { M_FOX = 0, M_SEL = 1, M_WIN = 2, M_CMP = 3 };
struct Run {
    const f16* K; const f16* V; int ldk;
    const float* kbias;
    int P0;
    int ntiles;
    f16* O;
};

template <int MODE>
__device__ __forceinline__ void run_tiles(const Run R, char* lds, const h8 (&qr)[8], int qlo, const float* tb, unsigned selrow, const int tid_in) {
    int tid = tid_in; asm volatile("" : "+v"(tid));
    const int wid = __builtin_amdgcn_readfirstlane(tid >> 6), lane = tid & 63, r32 = lane & 31, hi = lane >> 5;
    char* V_lds = lds + L_V; char* K_lds = lds + L_K;
    float* wsf = (float*)(lds + L_WSF) + wid * 64; float* li_l = wsf, * al_l = wsf + 32;
    float* KBl = (float*)(lds + L_KB);
    const int* TL = (const int*)(lds + L_TL);
    const int vb0 = (int)(uintptr_t)V_lds + v_rd_base(lane);
    float m_reg = -1e30f, l_reg = 0.f; f32x16 o[4] = {};
    const int NTL = R.ntiles;
    int koff[2], voff[2];
#pragma unroll
    for (int i = 0; i < 2; ++i) { const int q = (wid * 2 + i) * 64 + lane;
        { const int row = q >> 4, ch = (q & 15) ^ (row & 7); koff[i] = row * R.ldk + ch * 8; }
        { const int sub = q >> 5, r16 = q & 31, kk = (sub >> 2) * 8 + (r16 >> 2), c = (sub & 3) * 32 + (r16 & 3) * 8;
          const int k = (kk & ~0xC) | ((kk & 4) << 1) | ((kk & 8) >> 1); voff[i] = k * R.ldk + c; } }
    float skb = 0.f;
#define ISSUE(j, bf) do { const f16* kt_ = R.K + (size_t)((j) * KVBLK) * R.ldk; const f16* vt_ = R.V + (size_t)((j) * KVBLK) * R.ldk; \
        _Pragma("unroll") for (int i_ = 0; i_ < 2; ++i_) { \
            __builtin_amdgcn_global_load_lds((const unsigned*)(kt_ + koff[i_]), (LAS unsigned*)(uintptr_t)(unsigned)((int)(uintptr_t)K_lds + (bf) * SHM_K + (wid * 2 + i_) * 1024), 16, 0, 0); \
            __builtin_amdgcn_global_load_lds((const unsigned*)(vt_ + voff[i_]), (LAS unsigned*)(uintptr_t)(unsigned)((int)(uintptr_t)V_lds + (bf) * SHM_V + (wid * 2 + i_) * 1024), 16, 0, 0); } \
        if (MODE == M_FOX) { if (tid < 64) skb = -R.kbias[(j) * KVBLK + tid] * LOG2E; } } while (0)
    if (NTL > 0) ISSUE(TL[0], 0);
#pragma unroll 1
    for (int t = 0; t < NTL; ++t) {
        const int buf = t & 1, j = TL[t];
        if (MODE == M_FOX) { if (tid < 64) KBl[buf * 64 + tid] = skb; }
        asm volatile("s_waitcnt vmcnt(0)" ::: "memory");
        __syncthreads();
        if (t + 1 < NTL) ISSUE(TL[t + 1], buf ^ 1);
        f32x16 p0, p1;
        const int kb_ = (MODE == M_CMP) ? 0 : j * KVBLK;
        {
            qkt(p0, p1, K_lds + buf * SHM_K, r32, hi, qr);
            if (MODE == M_FOX) {
                const float* kbp = KBl + buf * 64 + 4 * hi;
#pragma unroll
                for (int g = 0; g < 4; ++g) { const f32x4 b0 = *(const f32x4*)(kbp + 8 * g), b1 = *(const f32x4*)(kbp + 32 + 8 * g);
#pragma unroll
                    for (int i = 0; i < 4; ++i) { p0[4 * g + i] = fmaf(p0[4 * g + i], C2, b0[i]); p1[4 * g + i] = fmaf(p1[4 * g + i], C2, b1[i]); } }
                if (kb_ + KVBLK - 1 > qlo) mask_tile(p0, p1, qlo + r32 - 4 * hi - kb_, 0x7fffffffu);
            } else if (MODE == M_CMP) {
#pragma unroll
                for (int r = 0; r < 16; ++r) { p0[r] *= C2; p1[r] *= C2; }
                const int dq3 = qlo + r32 - 31 - 16 * (j * 64 + 4 * hi);
                const float NEG = -__builtin_inff();
                const bool near = (qlo - 31 - 16 * (j * 64 + 63)) < 113;
#pragma unroll
                for (int r = 0; r < 16; ++r) { const int c = (r & 3) + 8 * (r >> 2); const int d0 = dq3 - 16 * c, d1 = d0 - 512;
                    if (near) { p0[r] += tb[d0 < 0 ? 0 : (d0 > 127 ? 127 : d0)]; p1[r] += tb[d1 < 0 ? 0 : (d1 > 127 ? 127 : d1)]; }
                    if (d0 < 0) p0[r] = NEG; if (d1 < 0) p1[r] = NEG;
                    if ((r & 3) == 3) SBAR(); }
            } else {
#pragma unroll
                for (int r = 0; r < 16; ++r) { p0[r] *= C2; p1[r] *= C2; }
                const int dq = qlo + r32 - 4 * hi - kb_;
                if (qlo - (kb_ + KVBLK - 1) < 113) t5_bias(p0, p1, dq, tb);
                if (MODE == M_SEL) { if (kb_ + KVBLK - 1 > qlo) mask_tile(p0, p1, dq, 0x7fffffffu);
                    if (!((selrow >> j) & 1u)) { const float NEG = -__builtin_inff();
#pragma unroll
                        for (int r = 0; r < 16; ++r) { p0[r] = NEG; p1[r] = NEG; } } }
                else { if (kb_ + KVBLK - 1 > qlo || kb_ <= qlo + 31 - WIN) mask_tile(p0, p1, dq, (unsigned)WIN); }
            }
            float mn, alpha; h8 pa0, pa1, pa2, pa3;
            partialSM(p0, p1, m_reg, mn, alpha);
            finishSM(p0, p1, mn, alpha, l_reg, pa0, pa1, pa2, pa3);
            if (__any(alpha < 1.f)) { if (hi == 0) al_l[r32] = alpha; asm volatile("s_waitcnt lgkmcnt(0)" ::: "memory");
#pragma unroll
                for (int d_ = 0; d_ < 4; ++d_)
#pragma unroll
                    for (int r = 0; r < 16; ++r) o[d_][r] *= al_l[crow(r, hi)]; }
            SBAR();
            pv_tile(o, vb0 + buf * SHM_V, pa0, pa1, pa2, pa3);
        }
    }
#undef ISSUE
    if (hi == 0) li_l[r32] = l_reg; asm volatile("s_waitcnt lgkmcnt(0)" ::: "memory");
    f16* Ow = R.O + (size_t)(qlo - R.P0) * 1024;
#pragma unroll
    for (int r = 0; r < 16; ++r) { const int orow = crow(r, hi); const float lv = li_l[orow]; const float rl = lv > 0.f ? __builtin_amdgcn_rcpf(lv) : 0.f;
#pragma unroll
        for (int d0 = 0; d0 < 4; ++d0) { const float v = o[d0][r] * rl; const float vn = __shfl_xor(v, 1);
            if ((r32 & 1) == 0) *(unsigned*)(Ow + (size_t)orow * 1024 + d0 * 32 + r32) = cvtpk(v, vn); } }
    __syncthreads();
}

__device__ __forceinline__ int fill_tiles_range(char* lds, int j_lo, int j_hi, int tid) {
    int* TL = (int*)(lds + L_TL);
    if (tid < j_hi - j_lo) TL[tid] = j_lo + tid;
    __syncthreads();
    return j_hi - j_lo;
}

__device__ __forceinline__ void fox_unit(const Args& a, char* lds, int b, int h, int qt) {
    int tid_ = threadIdx.x; asm volatile("" : "+v"(tid_));
    const int tid = tid_, wid = __builtin_amdgcn_readfirstlane(tid >> 6), lane = tid & 63, r32 = lane & 31, hi = lane >> 5;
    unsigned char* wsb = a.ws; asm volatile("" : "+s"(wsb));
    const f16* PROJ = (const f16*)(wsb + WS_PROJ);
    const int P0 = qt * 256, qlo = P0 + wid * 32;
    h8 qr[8];
    { const f16* qp = PROJ + (size_t)(b * SEQ + qlo + r32) * NP + C_FQ + h * 128 + hi * 8;
#pragma unroll
      for (int d0 = 0; d0 < 8; ++d0) qr[d0] = *(const h8*)(qp + d0 * 16); }
    Run R; R.K = PROJ + (size_t)(b * SEQ) * NP + C_FK + h * 128; R.V = PROJ + (size_t)(b * SEQ) * NP + C_FV + h * 128; R.ldk = NP;
    R.kbias = (const float*)(wsb + WS_CUM) + (size_t)(b * 8 + h) * SEQ; R.P0 = P0;
    R.O = (f16*)(wsb + WS_OF) + (size_t)(b * SEQ + P0) * 1024 + h * 128;
    R.ntiles = fill_tiles_range(lds, 0, (P0 + 255) / KVBLK + 1, tid);
    run_tiles<M_FOX>(R, lds, qr, qlo, nullptr, 0u, tid);
}

__device__ __forceinline__ unsigned topk_mask32(const float (&impin)[32], int t) {
    float v[32]; const int cur = t >> 6;
#pragma unroll
    for (int j = 0; j < 32; ++j) { float x = impin[j]; if (j == 0 || j == cur || j == cur - 1) x = 1e6f; if (j > cur) x = -__builtin_inff(); v[j] = x; }
    unsigned mask = 0u;
#pragma unroll 1
    for (int it = 0; it < NSEL; ++it) { float best = -__builtin_inff(); int bi = -1;
#pragma unroll
        for (int j = 0; j < 32; ++j) if (v[j] > best) { best = v[j]; bi = j; }
        if (bi < 0) break;
        mask |= 1u << bi;
#pragma unroll
        for (int j = 0; j < 32; ++j) if (j == bi) v[j] = -__builtin_inff(); }
    return mask;
}
__device__ __forceinline__ void nsa_unit(const Args& a, char* lds, int b, int kvh, int qt) {
    int tid_ = threadIdx.x; asm volatile("" : "+v"(tid_));
    const int tid = tid_, wid = __builtin_amdgcn_readfirstlane(tid >> 6), lane = tid & 63, r32 = lane & 31, hi = lane >> 5;
    unsigned char* wsb = a.ws; asm volatile("" : "+s"(wsb));
    const f16* PROJ = (const f16*)(wsb + WS_PROJ);
    const int P0 = qt * 64, qlo = P0 + (wid >> 2) * 32, g4 = wid & 3, hq = kvh * 4 + g4;
    const float* tb = (const float*)(lds + L_TBL) + hq * 128;
    h8 qr[8];
    { const f16* qp = PROJ + (size_t)(b * SEQ + qlo + r32) * NP + C_NQ + hq * 128 + hi * 8;
#pragma unroll
      for (int d0 = 0; d0 < 8; ++d0) qr[d0] = *(const h8*)(qp + d0 * 16); }
    const f16* KC = (const f16*)(wsb + WS_KC) + (size_t)(b * 2 + kvh) * 128 * 128; const f16* VC = (const f16*)(wsb + WS_VC) + (size_t)(b * 2 + kvh) * 128 * 128;
#ifndef NSA_SKIP_A
    {
        char* K_lds = lds + L_K;
        const int sr = tid >> 4, sc = (tid & 15) * 8, kws = KSWZ(sr, sc * 2);
#pragma unroll
        for (int T = 0; T < 2; ++T) { *(h8*)(K_lds + T * SHM_K + kws) = *(const h8*)(KC + (size_t)(T * 64 + sr) * 128 + sc);
            *(h8*)(K_lds + T * SHM_K + kws + 32 * 256) = *(const h8*)(KC + (size_t)(T * 64 + 32 + sr) * 128 + sc); }
        __syncthreads();
        f32x16 x[4];
        qkt(x[0], x[1], K_lds, r32, hi, qr); qkt(x[2], x[3], K_lds + SHM_K, r32, hi, qr);
        const float NEG = -__builtin_inff();
        float mx = NEG;
#pragma unroll
        for (int T = 0; T < 2; ++T) { const int dq3 = qlo + r32 - 31 - 16 * (T * 64 + 4 * hi);
#pragma unroll
            for (int r = 0; r < 16; ++r) { const int c = (r & 3) + 8 * (r >> 2); const int d0 = dq3 - 16 * c, d1 = d0 - 512;
                float v0 = x[2 * T][r] * C2 + tb[d0 < 0 ? 0 : (d0 > 127 ? 127 : d0)], v1 = x[2 * T + 1][r] * C2 + tb[d1 < 0 ? 0 : (d1 > 127 ? 127 : d1)];
                if (d0 < 0) v0 = NEG; if (d1 < 0) v1 = NEG;
                x[2 * T][r] = v0; x[2 * T + 1][r] = v1; mx = fmaxf(mx, fmaxf(v0, v1)); } }
        mx = fmaxf(mx, __shfl_xor(mx, 32));
        const float mref = mx == NEG ? 0.f : mx;
        float sum = 0.f;
#pragma unroll
        for (int q = 0; q < 4; ++q)
#pragma unroll
            for (int r = 0; r < 16; ++r) { const float e = __builtin_amdgcn_exp2f(x[q][r] - mref); x[q][r] = e; sum += e; }
        sum += __shfl_xor(sum, 32);
        const float inv = sum > 0.f ? 1.f / sum : 0.f;
        float own[16], cout[16], cin[16];
#pragma unroll
        for (int q = 0; q < 4; ++q)
#pragma unroll
            for (int g = 0; g < 4; ++g) { const float e0 = x[q][4 * g], e1 = x[q][4 * g + 1], e2 = x[q][4 * g + 2], e3 = x[q][4 * g + 3];
                own[4 * q + g] = (2.f * (e0 + e1 + e2) + e3) * inv; cout[4 * q + g] = e3 * inv; }
#pragma unroll
        for (int k = 0; k < 16; ++k) cin[k] = __shfl_xor(cout[k], 32);
        float* IMPH = (float*)(lds + L_IMPH) + (size_t)(g4 * 64 + (wid >> 2) * 32 + r32) * 33;
#pragma unroll
        for (int k = 0; k < 16; ++k) { const float ci = hi ? cin[k] : (k > 0 ? cin[k - 1] : 0.f);
            const int q = k >> 2, g = k & 3, j = 16 * (q >> 1) + 8 * (q & 1) + 2 * g + hi;
            IMPH[j] = own[k] + ci; }
        __syncthreads();
        if (tid < 64) { const float* ip = (const float*)(lds + L_IMPH) + tid * 33; float imp[32];
#pragma unroll
            for (int j = 0; j < 32; ++j) imp[j] = ((ip[j] + ip[64 * 33 + j]) + ip[2 * 64 * 33 + j]) + ip[3 * 64 * 33 + j];
            unsigned m = topk_mask32(imp, P0 + tid);
            ((unsigned*)(lds + L_SELM))[tid] = m;
#pragma unroll
            for (int o_ = 1; o_ < 64; o_ <<= 1) m |= __shfl_xor(m, o_);
            if (tid == 0) *(unsigned*)(lds + L_UNION) = m; }
        __syncthreads();
    }
#endif
    const unsigned selrow = ((const unsigned*)(lds + L_SELM))[(wid >> 2) * 32 + r32];
    const unsigned uni = *(const unsigned*)(lds + L_UNION);
    Run R; R.kbias = nullptr; R.P0 = P0;
    const size_t obase = (size_t)(b * SEQ + P0) * 1024 + hq * 128;
    R.K = KC; R.V = VC; R.ldk = 128; R.O = (f16*)(wsb + WS_OC) + obase; R.ntiles = fill_tiles_range(lds, 0, 2, tid);
#ifndef NSA_SKIP_CMP
    run_tiles<M_CMP>(R, lds, qr, qlo, tb, 0u, tid);
#endif
    { int* TL = (int*)(lds + L_TL);
      if (tid == 0) { int n = 0; for (int j = 0; j < 32; ++j) if ((uni >> j) & 1u) TL[n++] = j; TL[39] = n; }
      __syncthreads(); }
    R.K = PROJ + (size_t)(b * SEQ) * NP + C_NK + 256 + kvh * 128; R.V = PROJ + (size_t)(b * SEQ) * NP + C_NV + 256 + kvh * 128; R.ldk = NP;
    R.O = (f16*)(wsb + WS_OS) + obase; R.ntiles = ((const int*)(lds + L_TL))[39];
#ifndef NSA_SKIP_SEL
    run_tiles<M_SEL>(R, lds, qr, qlo, tb, selrow, tid);
#endif
    { int jl = (P0 - (WIN - 1)); jl = jl > 0 ? jl / KVBLK : 0;
      R.K = PROJ + (size_t)(b * SEQ) * NP + C_NK + 512 + kvh * 128; R.V = PROJ + (size_t)(b * SEQ) * NP + C_NV + 512 + kvh * 128;
      R.O = (f16*)(wsb + WS_OW) + obase; R.ntiles = fill_tiles_range(lds, jl, (P0 + 63) / KVBLK + 1, tid);
#ifndef NSA_SKIP_WIN
      run_tiles<M_WIN>(R, lds, qr, qlo, tb, 0u, tid);
#endif
    }
}

__device__ __forceinline__ void attn_phase(const Args& a, char* lds, int bid, int nblk) {
    { const float* TBLR = (const float*)(a.ws + WS_TBL) + 1024; float* t = (float*)(lds + L_TBL);
      for (int i = threadIdx.x; i < 1024; i += NT) t[i] = TBLR[i] * LOG2E; }
    __syncthreads();
    for (int i = bid; i < 256; i += nblk) {
        const int qt_f = i & 7, k = (i >> 3) & 3, bh_f = i >> 3, rest = i >> 5, qt_n = 31 - 4 * qt_f - k;
        fox_unit(a, lds, bh_f >> 3, bh_f & 7, qt_f);
        nsa_unit(a, lds, rest >> 1, rest & 1, qt_n);
    }
}
#undef KSWZ
#undef SBAR
}
constexpr int LDS_BYTES = 147456;
constexpr int LDSCTL_OFF = 131072, MISC_OFF = LDSCTL_OFF + 320;
constexpr int CW_BAR = 4096;
constexpr int N_PHASES = 10;

__device__ __forceinline__ void gemm_stage(const Args& a, LAS unsigned char* lds, int stage) {
    unsigned char* ws = a.ws; const float* MOD = (const float*)(ws + WS_MOD);
    pg8::StaticOrder S;
    if (stage == 2) { pg8::Gemm g{(const f16*)(ws + WS_H), (const f16*)(ws + WS_WIN), NTOK, NP, DM}; S.init(NTOK, NP, gridDim.x, blockIdx.x);
        pg8::EpiProj E{(f16*)(ws + WS_PROJ), NP}; pg8::gemm_phase<pg8::EpiProj, pg8::StaticOrder, PG8_ALIGN, PG8_SP2>(lds, g, S, E); }
    else if (stage == 6) { pg8::Gemm g{(const f16*)(ws + WS_H), (const f16*)(ws + WS_WOUT), NTOK, DM, DM}; S.init(NTOK, DM, gridDim.x, blockIdx.x);
        pg8::EpiRes E{a.in[I_X], a.out, MOD + 2 * DM}; pg8::gemm_phase<pg8::EpiRes, pg8::StaticOrder, PG8_ALIGN, PG8_SP2>(lds, g, S, E); }
    else if (stage == 8) { pg8::Gemm g{(const f16*)(ws + WS_H), (const f16*)(ws + WS_WGU), NTOK, NGU, DM}; S.init(NTOK, NGU, gridDim.x, blockIdx.x);
        pg8::EpiGU E{(f16*)(ws + WS_PROJ)}; pg8::gemm_phase<pg8::EpiGU, pg8::StaticOrder, PG8_ALIGN, PG8_SP2>(lds, g, S, E); }
    else { pg8::Gemm g{(const f16*)(ws + WS_PROJ), (const f16*)(ws + WS_WDN), NTOK, DM, DFF}; S.init(NTOK, DM, gridDim.x, blockIdx.x);
        pg8::EpiRes E{a.out, a.out, MOD + 5 * DM}; pg8::gemm_phase<pg8::EpiRes, pg8::StaticOrder, PG8_ALIGN, PG8_SP2>(lds, g, S, E); }
}

__global__ void __launch_bounds__(NT, 2) k_mega(Args a) {
    extern __shared__ __attribute__((aligned(16))) unsigned char lds_raw[];
    LAS char* lds = (LAS char*)lds_raw;
    const int bid = blockIdx.x, nblk = gridDim.x, tid = threadIdx.x;
    for (int u = tid; u < (LDS_BYTES - LDSCTL_OFF) / 4; u += NT) ((LAS unsigned*)(lds + LDSCTL_OFF))[u] = 0u;
    __syncthreads();
    unsigned* ctl = (unsigned*)(a.ws + WS_CTL);
    XcdBarrier bar = xcd_barrier_post(ctl + CW_BAR + a.li * XCD_BAR_WORDS, (volatile LAS unsigned*)(lds + MISC_OFF) + 8);
    const int lo = a.ph_lo, hi = a.ph_hi;
#define IN(k) (lo <= (k) && (k) < hi)
#define SEAM(k) do { if (IN(k) && IN((k) + 1)) xcd_barrier(bar); } while (0)
#ifndef REPEAT_PHASE
#define REPEAT_PHASE -1
#endif
#define REP(k) for (int rep_ = 0; rep_ < ((k) == REPEAT_PHASE ? 2 : 1); ++rep_, ((k) == REPEAT_PHASE && rep_ == 1 ? xcd_barrier(bar) : (void)0))
    if (IN(0)) REP(0) { stage_prep(a, bid, nblk, lds); } SEAM(0);
    if (IN(1)) REP(1) { stage_norm(a, bid, nblk, lds, 0); } SEAM(1);
    if (IN(2)) REP(2) { gemm_stage(a, (LAS unsigned char*)lds_raw, 2); } SEAM(2);
    if (IN(3)) {
#if !NAIVE_ATTN
        for (int task = bid; task < 128; task += nblk) compress_task(a, (char*)lds_raw, task);
#endif
        post_norms(a, bid, nblk); post_cumsum(a, bid, nblk); } SEAM(3);
    if (IN(4)) REP(4) {
#if !NAIVE_ATTN
        att::attn_phase(a, (char*)lds_raw, bid, nblk);
#endif
    } SEAM(4);
    if (IN(5)) REP(5) { stage_ynorm(a, bid, nblk); } SEAM(5);
    if (IN(6)) REP(6) { gemm_stage(a, (LAS unsigned char*)lds_raw, 6); } SEAM(6);
    if (IN(7)) REP(7) { stage_norm(a, bid, nblk, lds, 1); } SEAM(7);
    if (IN(8)) REP(8) { gemm_stage(a, (LAS unsigned char*)lds_raw, 8); } SEAM(8);
    if (IN(9)) { gemm_stage(a, (LAS unsigned char*)lds_raw, 9); }
#undef IN
#undef SEAM
}

extern "C" void kernel_launch(void* const* d_in, const int* in_sizes, int n_in, void* d_out, int out_size, void* d_ws, size_t ws_size, hipStream_t stream) {
    static int grid = 0;
    if (grid == 0) {
        if (n_in != 21 || out_size != NTOK * DM || ws_size < WS_END) { fprintf(stderr, "kernel_launch: unexpected problem (n_in %d out %d ws %zu)\n", n_in, out_size, ws_size); grid = -1; return; }
        int dev = 0, cus = 0, per_cu = 0;
        hipGetDevice(&dev); hipDeviceGetAttribute(&cus, hipDeviceAttributeMultiprocessorCount, dev);
        hipFuncSetAttribute((const void*)k_mega, hipFuncAttributeMaxDynamicSharedMemorySize, LDS_BYTES);
        if (hipOccupancyMaxActiveBlocksPerMultiprocessor(&per_cu, (const void*)k_mega, NT, LDS_BYTES) != hipSuccess || per_cu < 1) { fprintf(stderr, "kernel_launch: occupancy query says %d blocks per CU\n", per_cu); per_cu = 1; }
        (void)hipGetLastError();
        grid = (cus > 0 ? cus : 256) * 1;
    }
    if (grid < 0) return;
    hipMemsetAsync((char*)d_ws + WS_CTL, 0, CTL_BYTES, stream);
    Args a{};
    for (int i = 0; i < 21; ++i) a.in[i] = (const float*)d_in[i];
    a.out = (float*)d_out; a.ws = (unsigned char*)d_ws;
#define MEGA(lo_, hi_, li_) do { a.ph_lo = (lo_); a.ph_hi = (hi_); a.li = (li_); hipLaunchKernelGGL(k_mega, dim3(grid), dim3(NT), LDS_BYTES, stream, a); } while (0)
#if NAIVE_ATTN
    MEGA(0, 3, 0);
    hipLaunchKernelGGL(naive_compress, dim3(2048), dim3(128), 0, stream, a);
    MEGA(3, 4, 1);
    hipLaunchKernelGGL(naive_fox, dim3(256), dim3(256), 0, stream, a);
    hipLaunchKernelGGL(naive_cmp, dim3(256), dim3(256), 0, stream, a);
    hipLaunchKernelGGL(naive_topk, dim3(NTOK * 2 / 256), dim3(256), 0, stream, a);
    hipLaunchKernelGGL(naive_selwin, dim3(256), dim3(256), 0, stream, a);
    MEGA(5, 10, 2);
#elif PER_PHASE
    for (int p = 0; p < N_PHASES; ++p) MEGA(p, p + 1, 0);
#else
    MEGA(0, N_PHASES, 0);
#endif
#undef MEGA
}
```

```cpp
#include <hip/hip_runtime.h>
#include <cstdint>
#include <cstdio>

#define GAS __attribute__((address_space(1)))
#define LAS __attribute__((address_space(3)))
typedef _Float16 f16;
typedef _Float16 h8 __attribute__((ext_vector_type(8)));
typedef _Float16 h4 __attribute__((ext_vector_type(4)));
typedef _Float16 h2 __attribute__((ext_vector_type(2)));
typedef float f32x2 __attribute__((ext_vector_type(2)));
typedef float f32x4 __attribute__((ext_vector_type(4)));
typedef float f32x16 __attribute__((ext_vector_type(16)));
typedef unsigned u32x2 __attribute__((ext_vector_type(2)));
typedef unsigned u32x4 __attribute__((ext_vector_type(4)));

constexpr int NB = 4, SEQ = 2048, DM = 2048, NTOK = NB * SEQ, HD = 128;
constexpr int NFH = 8, NNH = 8, NKV = 2, GRP = 4;
constexpr int INW = 5664, NP = 5888, DFF = 5632, NGU = 2 * DFF, NMOD = 6 * DM;
constexpr int NCMP = 127, NSLC = 32, NSEL = 8, WIN = 512;
constexpr int C_FQ = 0, C_FK = 1024, C_FV = 2048, C_NQ = 3072, C_NK = 4096, C_NV = 4864, C_FF = 5632, C_NG = 5640;
constexpr float SCALE = 0.08838834764831845f, EPS = 1e-6f, LOG2E = 1.4426950408889634f;

constexpr size_t MiB = 1u << 20;
constexpr size_t WS_CTL = 0, CTL_BYTES = 1 * MiB;
constexpr size_t WS_MODP = 1 * MiB;
constexpr size_t WS_MOD = 2 * MiB;
constexpr size_t WS_CUM = 2 * MiB + 256 * 1024;
constexpr size_t WS_KC = 2 * MiB + 512 * 1024;
constexpr size_t WS_VC = 2 * MiB + 768 * 1024;
constexpr size_t WS_TBL = 3 * MiB;
constexpr size_t WS_B1 = 3 * MiB + 16 * 1024;
constexpr size_t WS_W2T = 3 * MiB + 64 * 1024;
constexpr size_t WS_W1T = 4 * MiB;
constexpr size_t WS_SEL = 6 * MiB;
constexpr size_t WS_WIN = 8 * MiB;
constexpr size_t WS_WOUT = 31 * MiB;
constexpr size_t WS_WGU = 39 * MiB;
constexpr size_t WS_WDN = 83 * MiB;
constexpr size_t WS_H = 105 * MiB;
constexpr size_t WS_PROJ = 137 * MiB;
constexpr size_t WS_OF = 229 * MiB, WS_OC = 245 * MiB, WS_OS = 261 * MiB, WS_OW = 277 * MiB;
constexpr size_t WS_SCR = 293 * MiB;
constexpr size_t WS_END = 325 * MiB;

struct Args {
    const float* in[21];
    float* out;
    unsigned char* ws;
    int ph_lo, ph_hi, li, pad;
};
enum { I_X = 0, I_C, I_ADAW, I_ADAB, I_G1, I_G2, I_WIN, I_FB, I_FQG, I_FKG, I_NQG, I_NKG, I_POS, I_W1, I_W2, I_RB, I_MOG, I_WOUT, I_WG, I_WU, I_WD };

__device__ __forceinline__ float wave_sum(float v) {
#pragma unroll
    for (int o = 1; o < 64; o <<= 1) v += __shfl_xor(v, o);
    return v;
}
__device__ __forceinline__ float silu_f(float x) { return x / (1.f + __expf(-x)); }
__device__ __forceinline__ float sigmoid_f(float x) { return 1.f / (1.f + __expf(-x)); }
__device__ __forceinline__ int t5_bucket(int d) {
    if (d < 16) return d < 0 ? 0 : d;
    const int thr[15] = {19, 21, 24, 27, 31, 35, 40, 46, 52, 59, 67, 77, 87, 99, 113};
    int b = 16;
#pragma unroll
    for (int i = 0; i < 15; ++i) b += (d >= thr[i]) ? 1 : 0;
    return b;
}
__device__ __forceinline__ int win_src_col(int n) {
    if (n < 3072) return n;
    if (n < 4096) return 3080 + (n - 3072);
    if (n < 4864) return 4104 + (n - 4096);
    if (n < 5632) return 4872 + (n - 4864);
    if (n < 5640) return 3072 + (n - 5632);
    if (n < 5664) return n;
    return -1;
}
constexpr int NT = 512, NWV = 8;

__device__ __forceinline__ void transpose_item(const float* W, const float* W2, int Nsrc, int K, f16* WT, int mode, LAS float* scr, int kb, int nb, int lane) {
    const int k0 = 64 * kb, n0 = 32 * nb;
    const int nl = n0 + (lane & 31);
    int sc; const float* src = W;
    if (mode == 0) sc = win_src_col(nl);
    else if (mode == 1) sc = nl;
    else { const int p = nl >> 8, r = nl & 255; sc = 128 * p + (r & 127); src = (r < 128) ? W : W2; }
    float v[32];
#pragma unroll
    for (int i = 0; i < 32; ++i) { const int kk = 2 * i + (lane >> 5); v[i] = (sc >= 0) ? __builtin_nontemporal_load(src + (size_t)(k0 + kk) * Nsrc + sc) : 0.f; }
#pragma unroll
    for (int i = 0; i < 32; ++i) { const int kk = 2 * i + (lane >> 5); scr[kk * 33 + (lane & 31)] = v[i]; }
    asm volatile("s_waitcnt lgkmcnt(0)" ::: "memory");
    const int c = lane & 7;
#pragma unroll
    for (int j = 0; j < 4; ++j) { const int n = (lane >> 3) + 8 * j; const LAS float* s = scr + (8 * c) * 33 + n;
        h8 o;
#pragma unroll
        for (int i = 0; i < 8; ++i) o[i] = (f16)s[i * 33];
        *(h8*)(WT + (size_t)(n0 + n) * K + k0 + 8 * c) = o; }
    asm volatile("s_waitcnt lgkmcnt(0)" ::: "memory");
}

__device__ __forceinline__ void stage_prep(const Args& a, int bid, int nblk, LAS char* lds) {
    const int tid = threadIdx.x, lane = tid & 63, wave = __builtin_amdgcn_readfirstlane(tid >> 6);
    unsigned char* ws = a.ws;
    {
        LAS float* scr = (LAS float*)(lds + wave * 8448);
        f16* WIN_T = (f16*)(ws + WS_WIN); f16* WOUT_T = (f16*)(ws + WS_WOUT); f16* WGU_T = (f16*)(ws + WS_WGU); f16* WDN_T = (f16*)(ws + WS_WDN);
        f16* W1T = (f16*)(ws + WS_W1T); f16* W2T = (f16*)(ws + WS_W2T);
        constexpr int I_IN = 32 * (NP / 32), I_OUT = 32 * (DM / 32), I_GU = 32 * (NGU / 32), I_DN = (DFF / 64) * (DM / 32), I_1 = 2 * 64 * 4, I_2 = 2 * 2 * 4;
        constexpr int NIT = I_IN + I_OUT + I_GU + I_DN + I_1 + I_2;
        const int gw = bid * NWV + wave, ngw = nblk * NWV;
        for (int it = gw; it < NIT; it += ngw) {
            int r = it;
            if (r < I_IN) { transpose_item(a.in[I_WIN], nullptr, INW, DM, WIN_T, 0, scr, r / (NP / 32), r % (NP / 32), lane); continue; } r -= I_IN;
            if (r < I_OUT) { transpose_item(a.in[I_WOUT], nullptr, DM, DM, WOUT_T, 1, scr, r / (DM / 32), r % (DM / 32), lane); continue; } r -= I_OUT;
            if (r < I_GU) { transpose_item(a.in[I_WG], a.in[I_WU], DFF, DM, WGU_T, 2, scr, r / (NGU / 32), r % (NGU / 32), lane); continue; } r -= I_GU;
            if (r < I_DN) { transpose_item(a.in[I_WD], nullptr, DM, DFF, WDN_T, 1, scr, r / (DM / 32), r % (DM / 32), lane); continue; } r -= I_DN;
            if (r < I_1) { const int wh = r / 256, q = r % 256; transpose_item(a.in[I_W1] + (size_t)wh * 4096 * 128, nullptr, 128, 4096, W1T + (size_t)wh * 128 * 4096, 1, scr, q / 4, q % 4, lane); continue; } r -= I_1;
            { const int wh = r / 8, q = r % 8; transpose_item(a.in[I_W2] + (size_t)wh * 128 * 128, nullptr, 128, 128, W2T + (size_t)wh * 128 * 128, 1, scr, q / 4, q % 4, lane); }
        }
    }
    __syncthreads();
    {
        LAS float* sc = (LAS float*)lds;
        LAS float* red = (LAS float*)(lds + 8192);
        float* MODP = (float*)(ws + WS_MODP);
        const float* cin = a.in[I_C]; const float* W = a.in[I_ADAW];
        const int tx = tid & 15, ty = tid >> 4;
        for (int it = bid; it < 192 * 4; it += nblk) {
            const int cc = it % 192, kc = it / 192, col0 = cc * 64, kbase = kc * 512;
            for (int i = tid; i < 4 * 512; i += NT) { const int b = i >> 9, k = i & 511; sc[i] = silu_f(cin[b * DM + kbase + k]); }
            __syncthreads();
            f32x4 acc[4] = {};
#pragma unroll 4
            for (int p = 0; p < 16; ++p) { const int kl = p * 32 + ty; const f32x4 w = *(const f32x4*)(W + (size_t)(kbase + kl) * NMOD + col0 + tx * 4);
#pragma unroll
                for (int b = 0; b < 4; ++b) acc[b] += w * sc[b * 512 + kl]; }
#pragma unroll
            for (int b = 0; b < 4; ++b) *(LAS f32x4*)(red + (ty * 4 + b) * 64 + tx * 4) = acc[b];
            __syncthreads();
            if (tid < 256) { const int b = tid >> 6, c = tid & 63; float s = 0.f;
#pragma unroll 8
                for (int y = 0; y < 32; ++y) s += red[(y * 4 + b) * 64 + c];
                MODP[((size_t)kc * 4 + b) * NMOD + col0 + c] = s; }
            __syncthreads();
        }
    }
    if (bid == 0) {
        float* TBL = (float*)(ws + WS_TBL); const float* rb = a.in[I_RB];
        for (int i = tid; i < 8 * 128; i += NT) { const int h = i >> 7, d = i & 127; const float v = rb[t5_bucket(d) * 8 + h]; TBL[i] = v; TBL[1024 + i] = v - rb[31 * 8 + h]; }
    }
    for (int it = bid; it < 64; it += nblk) {
        LAS float* red = (LAS float*)lds;
        const int wh = it >> 5, j = it & 31;
        const float* pos = a.in[I_POS] + wh * 4096 + j * 128; const float* w1 = a.in[I_W1] + ((size_t)wh * 4096 + j * 128) * 128;
        const int n = tid & 127, q = tid >> 7; float s = 0.f;
#pragma unroll 8
        for (int k = q; k < 128; k += 4) s += pos[k] * w1[(size_t)k * 128 + n];
        red[q * 128 + n] = s; __syncthreads();
        if (tid < 128) ((float*)(ws + WS_B1))[256 + it * 128 + tid] = red[tid] + red[128 + tid] + red[256 + tid] + red[384 + tid];
        __syncthreads();
    }
}

__device__ __forceinline__ void stage_norm(const Args& a, int bid, int nblk, LAS char* lds, int which) {
    const int tid = threadIdx.x, lane = tid & 63, wave = __builtin_amdgcn_readfirstlane(tid >> 6);
    unsigned char* ws = a.ws;
    const float* MODP = (const float*)(ws + WS_MODP); float* MOD = (float*)(ws + WS_MOD);
    const float* ada_b = a.in[I_ADAB];
    if (which == 0 && bid == 0 && tid < 256) {
        const float* B1P = (const float*)(ws + WS_B1) + 256; float s = 0.f; const int wh = tid >> 7, n = tid & 127;
        for (int j = 0; j < 32; ++j) s += B1P[(wh * 32 + j) * 128 + n];
        ((float*)(ws + WS_B1))[tid] = s; }
    if (which == 0) {
        for (int i = bid * NT + tid; i < 4 * NMOD; i += nblk * NT) { const int n = i % NMOD;
            MOD[i] = MODP[i] + MODP[4 * NMOD + i] + MODP[8 * NMOD + i] + MODP[12 * NMOD + i] + ada_b[n]; }
    }
    const float* X = which == 0 ? a.in[I_X] : (const float*)(ws + WS_OF); const float* gain = a.in[which == 0 ? I_G1 : I_G2];
    f16* H = (f16*)(ws + WS_H);
    LAS float* A_ = (LAS float*)lds; LAS float* B_ = (LAS float*)(lds + 8192);
    const int sh_off = which == 0 ? 0 : 3 * DM, sc_off = sh_off + DM;
    int cur_b = -1;
    for (int rb = bid; rb < NTOK / 32; rb += nblk) {
        const int b = rb / (SEQ / 32);
        if (b != cur_b) { __syncthreads();
            for (int k = tid; k < DM; k += NT) { float sc, sh;
                if (which == 0) { sc = ada_b[sc_off + k]; sh = ada_b[sh_off + k];
#pragma unroll
                    for (int kc = 0; kc < 4; ++kc) { sc += MODP[((size_t)kc * 4 + b) * NMOD + sc_off + k]; sh += MODP[((size_t)kc * 4 + b) * NMOD + sh_off + k]; } }
                else { sc = MOD[b * NMOD + sc_off + k]; sh = MOD[b * NMOD + sh_off + k]; }
                A_[k] = gain[k] * (1.f + sc); B_[k] = sh; }
            __syncthreads(); cur_b = b; }
#pragma unroll 1
        for (int rr = 0; rr < 4; ++rr) {
            const int m = rb * 32 + wave * 4 + rr;
            const f32x4* xr = (const f32x4*)(X + (size_t)m * DM);
            f32x4 v[8]; float ss = 0.f;
#pragma unroll
            for (int j = 0; j < 8; ++j) { v[j] = xr[j * 64 + lane]; ss += v[j].x * v[j].x + v[j].y * v[j].y + v[j].z * v[j].z + v[j].w * v[j].w; }
            const float r = rsqrtf(wave_sum(ss) * (1.f / DM) + EPS);
#pragma unroll
            for (int j = 0; j < 8; ++j) { const int k = j * 256 + lane * 4; const f32x4 aa = *(LAS f32x4*)(A_ + k), bb = *(LAS f32x4*)(B_ + k);
                h4 o; o.x = (f16)(v[j].x * r * aa.x + bb.x); o.y = (f16)(v[j].y * r * aa.y + bb.y); o.z = (f16)(v[j].z * r * aa.z + bb.z); o.w = (f16)(v[j].w * r * aa.w + bb.w);
                *(h4*)(H + (size_t)m * DM + k) = o; }
        }
    }
}

__device__ __forceinline__ void post_norms(const Args& a, int bid, int nblk) {
    const int tid = threadIdx.x, lane = tid & 63, wave = __builtin_amdgcn_readfirstlane(tid >> 6);
    f16* PROJ = (f16*)(a.ws + WS_PROJ);
    const int g = lane >> 4, l16 = lane & 15;
    float gq[8], gk[8], gnq[8], gk1[8], gk2[8];
#pragma unroll
    for (int i = 0; i < 8; ++i) { gq[i] = a.in[I_FQG][l16 * 8 + i]; gk[i] = a.in[I_FKG][l16 * 8 + i]; gnq[i] = a.in[I_NQG][l16 * 8 + i];
        gk1[i] = a.in[I_NKG][128 + l16 * 8 + i]; gk2[i] = a.in[I_NKG][256 + l16 * 8 + i]; }
    for (int m = bid * NWV + wave; m < NTOK; m += nblk * NWV) {
        f16* row = PROJ + (size_t)m * NP;
        h8 x[7]; int col[7];
#pragma unroll
        for (int it = 0; it < 7; ++it) { const int v = it * 4 + g;
            if (it < 2) col[it] = C_FQ + v * 128; else if (it < 4) col[it] = C_FK + (v - 8) * 128; else if (it < 6) col[it] = C_NQ + (v - 16) * 128;
            else col[it] = C_NK + (1 + ((v - 24) >> 1)) * 256 + ((v - 24) & 1) * 128;
            x[it] = *(const h8*)(row + col[it] + l16 * 8); }
#pragma unroll
        for (int it = 0; it < 7; ++it) {
            float f[8]; float ss = 0.f;
#pragma unroll
            for (int i = 0; i < 8; ++i) { f[i] = (float)x[it][i]; ss += f[i] * f[i]; }
            ss += __shfl_xor(ss, 1); ss += __shfl_xor(ss, 2); ss += __shfl_xor(ss, 4); ss += __shfl_xor(ss, 8);
            const float r = rsqrtf(ss * (1.f / 128.f) + EPS);
            h8 y;
#pragma unroll
            for (int i = 0; i < 8; ++i) { const float gg = it < 2 ? gq[i] : (it < 4 ? gk[i] : (it < 6 ? gnq[i] : (g < 2 ? gk1[i] : gk2[i]))); y[i] = (f16)(f[i] * r * gg); }
            *(h8*)(row + col[it] + l16 * 8) = y;
        }
    }
}
__device__ __forceinline__ void post_cumsum(const Args& a, int bid, int nblk) {
    const int tid = threadIdx.x, lane = tid & 63, wave = __builtin_amdgcn_readfirstlane(tid >> 6);
    const f16* PROJ = (const f16*)(a.ws + WS_PROJ); float* CUM = (float*)(a.ws + WS_CUM);
    for (int s = bid * NWV + wave; s < NB * NFH; s += nblk * NWV) {
        const int b = s >> 3, h = s & 7; const float fb = a.in[I_FB][h];
        float v[32]; float run = 0.f;
#pragma unroll
        for (int i = 0; i < 32; ++i) { const int t = lane * 32 + i; const float x = (float)PROJ[(size_t)(b * SEQ + t) * NP + C_FF + h] + fb;
            const float ls = fminf(x, 0.f) - log1pf(__expf(-fabsf(x))); run += ls; v[i] = run; }
        float incl = run;
#pragma unroll
        for (int o = 1; o < 64; o <<= 1) { const float n = __shfl_up(incl, o); if (lane >= o) incl += n; }
        const float excl = incl - run;
#pragma unroll
        for (int i = 0; i < 32; ++i) CUM[(size_t)s * SEQ + lane * 32 + i] = v[i] + excl;
    }
}

__device__ __forceinline__ void stage_ynorm(const Args& a, int bid, int nblk) {
    const int tid = threadIdx.x, lane = tid & 63, wave = __builtin_amdgcn_readfirstlane(tid >> 6);
    unsigned char* ws = a.ws;
    const f16* OF = (const f16*)(ws + WS_OF); const f16* OC = (const f16*)(ws + WS_OC); const f16* OS = (const f16*)(ws + WS_OS); const f16* OW = (const f16*)(ws + WS_OW);
    const f16* PROJ = (const f16*)(ws + WS_PROJ); f16* Y = (f16*)(ws + WS_H); const float* mog = a.in[I_MOG];
    for (int m = bid * NWV + wave; m < NTOK; m += nblk * NWV) {
        float f[16], n[16]; float ssf = 0.f, ssn = 0.f;
        const size_t o16 = (size_t)m * 1024 + lane * 16;
        const int hd = lane >> 3;
        const f16* gp = PROJ + (size_t)m * NP + C_NG + hd * 3;
        const float g0 = sigmoid_f((float)gp[0]), g1 = sigmoid_f((float)gp[1]), g2 = sigmoid_f((float)gp[2]);
#pragma unroll
        for (int hh = 0; hh < 2; ++hh) {
            const h8 xf = *(const h8*)(OF + o16 + hh * 8), xc = *(const h8*)(OC + o16 + hh * 8), xs = *(const h8*)(OS + o16 + hh * 8), xw = *(const h8*)(OW + o16 + hh * 8);
#pragma unroll
            for (int i = 0; i < 8; ++i) { f[hh * 8 + i] = (float)xf[i]; n[hh * 8 + i] = g0 * (float)xc[i] + g1 * (float)xs[i] + g2 * (float)xw[i];
                ssf += f[hh * 8 + i] * f[hh * 8 + i]; ssn += n[hh * 8 + i] * n[hh * 8 + i]; }
        }
        const float rf = rsqrtf(wave_sum(ssf) * (1.f / 1024.f) + EPS), rn = rsqrtf(wave_sum(ssn) * (1.f / 1024.f) + EPS);
#pragma unroll
        for (int hh = 0; hh < 2; ++hh) { h8 of, on;
#pragma unroll
            for (int i = 0; i < 8; ++i) { const int k = lane * 16 + hh * 8 + i; of[i] = (f16)(f[hh * 8 + i] * rf * mog[k]); on[i] = (f16)(n[hh * 8 + i] * rn * mog[1024 + k]); }
            *(h8*)(Y + (size_t)m * DM + lane * 16 + hh * 8) = of; *(h8*)(Y + (size_t)m * DM + 1024 + lane * 16 + hh * 8) = on; }
    }
}
#if NAIVE_BUILD
template <int MODE> __global__ void __launch_bounds__(256) naive_gemm(Args a) {
    unsigned char* ws = a.ws;
    const int tx = threadIdx.x & 15, ty = threadIdx.x >> 4;
    const int n0 = blockIdx.x * 64 + tx * 4, m0 = blockIdx.y * 64 + ty * 4;
    const f16* A; const f16* Bt; int K;
    if (MODE == 0) { A = (const f16*)(ws + WS_H); Bt = (const f16*)(ws + WS_WIN); K = DM; }
    else if (MODE == 1) { A = (const f16*)(ws + WS_H); Bt = (const f16*)(ws + WS_WOUT); K = DM; }
    else if (MODE == 2) { A = (const f16*)(ws + WS_H); Bt = (const f16*)(ws + WS_WGU); K = DM; }
    else { A = (const f16*)(ws + WS_PROJ); Bt = (const f16*)(ws + WS_WDN); K = DFF; }
    int brow[4], urow[4];
#pragma unroll
    for (int j = 0; j < 4; ++j) { const int n = n0 + j;
        if (MODE == 2) { brow[j] = 256 * (n >> 7) + (n & 127); urow[j] = brow[j] + 128; } else { brow[j] = n; urow[j] = n; } }
    float acc[4][4] = {}, accu[4][4] = {};
    for (int k = 0; k < K; k += 8) {
        h8 av[4], bv[4], uv[4];
#pragma unroll
        for (int i = 0; i < 4; ++i) av[i] = *(const h8*)(A + (size_t)(m0 + i) * K + k);
#pragma unroll
        for (int j = 0; j < 4; ++j) { bv[j] = *(const h8*)(Bt + (size_t)brow[j] * K + k); if (MODE == 2) uv[j] = *(const h8*)(Bt + (size_t)urow[j] * K + k); }
#pragma unroll
        for (int e = 0; e < 8; ++e)
#pragma unroll
            for (int i = 0; i < 4; ++i)
#pragma unroll
                for (int j = 0; j < 4; ++j) { acc[i][j] += (float)av[i][e] * (float)bv[j][e]; if (MODE == 2) accu[i][j] += (float)av[i][e] * (float)uv[j][e]; }
    }
    const float* MOD = (const float*)(ws + WS_MOD);
#pragma unroll
    for (int i = 0; i < 4; ++i) { const int m = m0 + i, b = m / SEQ;
#pragma unroll
        for (int j = 0; j < 4; ++j) { const int n = n0 + j;
            if (MODE == 0) ((f16*)(ws + WS_PROJ))[(size_t)m * NP + n] = (f16)acc[i][j];
            else if (MODE == 1) a.out[(size_t)m * DM + n] = a.in[I_X][(size_t)m * DM + n] + MOD[b * NMOD + 2 * DM + n] * acc[i][j];
            else if (MODE == 2) ((f16*)(ws + WS_PROJ))[(size_t)m * DFF + n] = (f16)(silu_f(acc[i][j]) * accu[i][j]);
            else a.out[(size_t)m * DM + n] = a.out[(size_t)m * DM + n] + MOD[b * NMOD + 5 * DM + n] * acc[i][j]; } }
}

__device__ __forceinline__ void row_step(bool valid, float bias, const h8 (&q)[16], const f16* krow, const f16* vrow, float& m, float& l, float (&o)[128]) {
    float s = 0.f;
#pragma unroll
    for (int c = 0; c < 16; ++c) { const h8 kv = *(const h8*)(krow + c * 8);
#pragma unroll
        for (int e = 0; e < 8; ++e) s += (float)q[c][e] * (float)kv[e]; }
    s = s * SCALE + bias;
    if (valid) {
        const float mn = fmaxf(m, s), al = __expf(m - mn), p = __expf(s - mn);
        l = l * al + p; m = mn;
#pragma unroll
        for (int c = 0; c < 16; ++c) { const h8 vv = *(const h8*)(vrow + c * 8);
#pragma unroll
            for (int e = 0; e < 8; ++e) o[c * 8 + e] = o[c * 8 + e] * al + p * (float)vv[e]; }
    }
}
__device__ __forceinline__ void row_store(f16* dst, float l, const float (&o)[128]) {
    const float inv = l > 0.f ? 1.f / l : 0.f;
#pragma unroll
    for (int c = 0; c < 16; ++c) { h8 w;
#pragma unroll
        for (int e = 0; e < 8; ++e) w[e] = (f16)(o[c * 8 + e] * inv);
        *(h8*)(dst + c * 8) = w; }
}

__global__ void __launch_bounds__(256) naive_fox(Args a) {
    unsigned char* ws = a.ws; const f16* PROJ = (const f16*)(ws + WS_PROJ); const float* CUM = (const float*)(ws + WS_CUM);
    const int tb = blockIdx.x & 7, h = (blockIdx.x >> 3) & 7, b = blockIdx.x >> 6, t = tb * 256 + threadIdx.x;
    h8 q[16];
#pragma unroll
    for (int c = 0; c < 16; ++c) q[c] = *(const h8*)(PROJ + (size_t)(b * SEQ + t) * NP + C_FQ + h * 128 + c * 8);
    const float* cum = CUM + (size_t)(b * 8 + h) * SEQ; const float cq = cum[t];
    float m = -1e30f, l = 0.f; float o[128];
#pragma unroll
    for (int i = 0; i < 128; ++i) o[i] = 0.f;
    const int jmax = tb * 256 + 255;
    for (int j = 0; j <= jmax; ++j) {
        const f16* kr = PROJ + (size_t)(b * SEQ + j) * NP + C_FK + h * 128; const f16* vr = PROJ + (size_t)(b * SEQ + j) * NP + C_FV + h * 128;
        row_step(j <= t, cq - cum[j], q, kr, vr, m, l, o);
    }
    row_store((f16*)(ws + WS_OF) + (size_t)(b * SEQ + t) * 1024 + h * 128, l, o);
}
__global__ void __launch_bounds__(256) naive_cmp(Args a) {
    unsigned char* ws = a.ws; const f16* PROJ = (const f16*)(ws + WS_PROJ); const float* TBL = (const float*)(ws + WS_TBL);
    const int tb = blockIdx.x & 7, h = (blockIdx.x >> 3) & 7, b = blockIdx.x >> 6, t = tb * 256 + threadIdx.x, kvh = h >> 2;
    const f16* KC = (const f16*)(ws + WS_KC) + (size_t)(b * 2 + kvh) * 128 * 128; const f16* VC = (const f16*)(ws + WS_VC) + (size_t)(b * 2 + kvh) * 128 * 128;
    float* PC = (float*)(ws + WS_SCR) + ((size_t)(b * SEQ + t) * 8 + h) * 128;
    h8 q[16];
#pragma unroll
    for (int c = 0; c < 16; ++c) q[c] = *(const h8*)(PROJ + (size_t)(b * SEQ + t) * NP + C_NQ + h * 128 + c * 8);
    float m = -1e30f, l = 0.f; float o[128];
#pragma unroll
    for (int i = 0; i < 128; ++i) o[i] = 0.f;
    for (int c = 0; c < NCMP; ++c) { const int d = t - (16 * c + 31); const int dd = d < 0 ? 0 : (d > 127 ? 127 : d);
        row_step(d >= 0, TBL[h * 128 + dd], q, KC + c * 128, VC + c * 128, m, l, o); }
    row_store((f16*)(ws + WS_OC) + (size_t)(b * SEQ + t) * 1024 + h * 128, l, o);
    const float inv = l > 0.f ? 1.f / l : 0.f;
    for (int c = 0; c < 128; ++c) { const int d = t - (16 * c + 31); float p = 0.f;
        if (c < NCMP && d >= 0) { const int dd = d > 127 ? 127 : d; float s = 0.f;
#pragma unroll
            for (int cc = 0; cc < 16; ++cc) { const h8 kv = *(const h8*)(KC + c * 128 + cc * 8);
#pragma unroll
                for (int e = 0; e < 8; ++e) s += (float)q[cc][e] * (float)kv[e]; }
            p = __expf(s * SCALE + TBL[h * 128 + dd] - m) * inv; }
        PC[c] = p; }
}
__device__ __forceinline__ unsigned topk_mask(const float (&impin)[32], int t) {
    float v[32]; const int cur = t >> 6;
#pragma unroll
    for (int j = 0; j < 32; ++j) { float x = impin[j]; if (j == 0 || j == cur || j == cur - 1) x = 1e6f; if (j > cur) x = -__builtin_inff(); v[j] = x; }
    unsigned mask = 0u;
#pragma unroll 1
    for (int it = 0; it < NSEL; ++it) { float best = -__builtin_inff(); int bi = -1;
#pragma unroll
        for (int j = 0; j < 32; ++j) if (v[j] > best) { best = v[j]; bi = j; }
        if (bi < 0) break;
        mask |= 1u << bi;
#pragma unroll
        for (int j = 0; j < 32; ++j) if (j == bi) v[j] = -__builtin_inff(); }
    return mask;
}
__global__ void __launch_bounds__(256) naive_topk(Args a) {
    unsigned char* ws = a.ws;
    const int idx = blockIdx.x * 256 + threadIdx.x; if (idx >= NTOK * 2) return;
    const int tok = idx >> 1, kvh = idx & 1, t = tok & (SEQ - 1);
    const float* PC = (const float*)(ws + WS_SCR) + ((size_t)tok * 8 + kvh * 4) * 128;
    float imp[32];
#pragma unroll
    for (int j = 0; j < 32; ++j) { float s = 0.f;
#pragma unroll
        for (int hh = 0; hh < 4; ++hh) { const float* p = PC + hh * 128;
            if (j > 0) s += p[4 * j - 1];
            s += 2.f * (p[4 * j] + p[4 * j + 1] + p[4 * j + 2]); if (4 * j + 3 < NCMP) s += p[4 * j + 3]; }
        imp[j] = s; }
    ((unsigned*)(ws + WS_SEL))[idx] = topk_mask(imp, t);
}
__global__ void __launch_bounds__(256) naive_selwin(Args a) {
    unsigned char* ws = a.ws; const f16* PROJ = (const f16*)(ws + WS_PROJ); const float* TBL = (const float*)(ws + WS_TBL);
    const int tb = blockIdx.x & 7, h = (blockIdx.x >> 3) & 7, b = blockIdx.x >> 6, t = tb * 256 + threadIdx.x, kvh = h >> 2;
    h8 q[16];
#pragma unroll
    for (int c = 0; c < 16; ++c) q[c] = *(const h8*)(PROJ + (size_t)(b * SEQ + t) * NP + C_NQ + h * 128 + c * 8);
    const unsigned mask = ((const unsigned*)(ws + WS_SEL))[(size_t)(b * SEQ + t) * 2 + kvh];
    float o[128];
    {
        float m = -1e30f, l = 0.f;
#pragma unroll
        for (int i = 0; i < 128; ++i) o[i] = 0.f;
        const int jmax = (tb * 256 + 255) >> 6;
        for (int j = 0; j <= jmax; ++j) { const bool sel = (mask >> j) & 1u;
            if (!__any(sel)) continue;
            for (int i = 0; i < 64; ++i) { const int s = j * 64 + i; const int d = t - s; const int dd = d < 0 ? 0 : (d > 127 ? 127 : d);
                const f16* kr = PROJ + (size_t)(b * SEQ + s) * NP + C_NK + 256 + kvh * 128; const f16* vr = PROJ + (size_t)(b * SEQ + s) * NP + C_NV + 256 + kvh * 128;
                row_step(sel && d >= 0, TBL[h * 128 + dd], q, kr, vr, m, l, o); } }
        row_store((f16*)(ws + WS_OS) + (size_t)(b * SEQ + t) * 1024 + h * 128, l, o);
    }
    {
        float m = -1e30f, l = 0.f;
#pragma unroll
        for (int i = 0; i < 128; ++i) o[i] = 0.f;
        int s0 = tb * 256 - (WIN - 1); if (s0 < 0) s0 = 0; const int s1 = tb * 256 + 255;
        for (int s = s0; s <= s1; ++s) { const int d = t - s; const int dd = d < 0 ? 0 : (d > 127 ? 127 : d);
            const f16* kr = PROJ + (size_t)(b * SEQ + s) * NP + C_NK + 512 + kvh * 128; const f16* vr = PROJ + (size_t)(b * SEQ + s) * NP + C_NV + 512 + kvh * 128;
            row_step(d >= 0 && d < WIN, TBL[h * 128 + dd], q, kr, vr, m, l, o); }
        row_store((f16*)(ws + WS_OW) + (size_t)(b * SEQ + t) * 1024 + h * 128, l, o);
    }
}
__global__ void __launch_bounds__(128) naive_compress(Args a) {
    unsigned char* ws = a.ws; const f16* PROJ = (const f16*)(ws + WS_PROJ);
    __shared__ float hid[128]; __shared__ float red[2];
    const int c = blockIdx.x & 127, kvh = (blockIdx.x >> 7) & 1, b = (blockIdx.x >> 8) & 3, wh = blockIdx.x >> 10, n = threadIdx.x;
    f16* dst = (f16*)(ws + (wh == 0 ? WS_KC : WS_VC)) + ((size_t)(b * 2 + kvh) * 128 + c) * 128;
    if (c >= NCMP) { dst[n] = (f16)0.f; return; }
    const float* w1 = a.in[I_W1] + (size_t)wh * 4096 * 128; const float* w2 = a.in[I_W2] + (size_t)wh * 128 * 128; const float* pos = a.in[I_POS] + wh * 4096;
    const int col = (wh == 0 ? C_NK : C_NV) + kvh * 128;
    float s = 0.f;
    for (int l = 0; l < 32; ++l) { const f16* xr = PROJ + (size_t)(b * SEQ + 16 * c + l) * NP + col;
        for (int d = 0; d < 128; ++d) s += ((float)xr[d] + pos[l * 128 + d]) * w1[(size_t)(l * 128 + d) * 128 + n]; }
    hid[n] = silu_f(s); __syncthreads();
    float o = 0.f;
    for (int k = 0; k < 128; ++k) o += hid[k] * w2[k * 128 + n];
    if (wh == 0) { float ss = wave_sum(o * o); if ((n & 63) == 0) red[n >> 6] = ss; __syncthreads(); ss = red[0] + red[1];
        o = o * rsqrtf(ss * (1.f / 128.f) + EPS) * a.in[I_NKG][n]; }
    dst[n] = (f16)o;
}
#endif
namespace pg8 {
#define PG8_LAS __attribute__((address_space(3)))
typedef _Float16 bf16_t;
typedef _Float16 bf16x8 __attribute__((ext_vector_type(8)));
typedef float f32x4 __attribute__((ext_vector_type(4)));
typedef unsigned u32x4 __attribute__((ext_vector_type(4)));
constexpr int BM = 256, BK = 64, HALF = 128, HTB = HALF * BK * 2  , STAGE_BYTES = 8 * HTB, NXCD = 8, WGM = 8;

__host__ __device__ __forceinline__ int lds_byte(int r, int c) { const int st = (r >> 4) * 2 + (c >> 5), rr = r & 15, cc = c & 31, ob = rr * 64 + cc * 2; return st * 1024 + (ob ^ (((ob >> 9) & 1) << 5)); }
__host__ __device__ __forceinline__ void stage_rc(int b, int& R, int& C) { const int st = b / 1024, sb = b % 1024, swz = sb ^ (((sb >> 9) & 1) << 5); R = (st >> 1) * 16 + swz / 64; C = (st & 1) * 32 + (swz % 64) / 2; }
__host__ __device__ __forceinline__ int perm32(int rho) { const int n = rho >> 4, i = rho & 15; return 8 * (i >> 2) + 4 * n + (i & 3); }

struct Unit { int pm, pn; };
struct Gemm { const bf16_t* A; const bf16_t* Bt; int M, N, K; };

struct StaticOrder {
    int nM, nN, nwg, G, c;
    __host__ __device__ void init(int M, int N, int G_, int c_) { nM = M / BM; nN = N / BM; nwg = nM * nN; G = G_; c = c_; }
    __host__ __device__ bool next(int i, Unit& u) const {
        const long L = (long)i * G + c; if (L >= nwg) return false;
        int wgid = (int)L; { const int q = nwg / NXCD, r = nwg % NXCD, xcd = wgid % NXCD, off = wgid / NXCD; wgid = (xcd < r ? xcd * (q + 1) : r * (q + 1) + (xcd - r) * q) + off; }
        const int nig = WGM * nN, gid = wgid / nig, fm = gid * WGM, gsz = (nM - fm) < WGM ? (nM - fm) : WGM;
        u.pm = fm + ((wgid % nig) % gsz); u.pn = (wgid % nig) / gsz; return true;
    }
    __device__ __forceinline__ void a_ready(const Unit&) const {}
    __device__ __forceinline__ void done(const Unit&) const {}
};

template <class Epi, class Sched, bool ALIGN_EPI = false, bool SP2 = false>
__device__ __forceinline__ void gemm_phase(PG8_LAS unsigned char* lds, const Gemm g, const Sched& S, const Epi& E) {
    const int tid = threadIdx.x, wid = __builtin_amdgcn_readfirstlane(tid >> 6), lane = tid & 63, wr = wid >> 2, wc = wid & 3, fr = lane & 15, fq = lane >> 4;
    const int K = g.K, nt = K / BK;
    unsigned voffA[2], voffB[2];
#pragma unroll
    for (int i = 0; i < 2; ++i) { int R, C; stage_rc(tid * 16 + i * 8192, R, C); const int Rb = Epi::PERM ? ((R & ~31) + perm32(R & 31)) : R;
        voffA[i] = (unsigned)(R * K + C) * 2u; voffB[i] = (unsigned)(Rb * K + C) * 2u; }
    const size_t kstep = (size_t)(BK * 2);
    const size_t hstep = (size_t)HALF * K * 2;
    const size_t tstep = 2 * hstep;
    const unsigned ldsw = (unsigned)wid * 1024u;
    const int aoff = lds_byte(wr * 64 + fr, fq * 8), boff = lds_byte(wc * 32 + fr, fq * 8);
#define PG8_SA(b, h) (((b) * 2 + (h)) * HTB)
#define PG8_SB(b, h) ((4 + (b) * 2 + (h)) * HTB)
#define PG8_STAGE(bufoff, gbase, voff) do { _Pragma("unroll") for (int _i = 0; _i < 2; ++_i) \
        __builtin_amdgcn_global_load_lds((const unsigned*)((const char*)(gbase) + (voff)[_i]), (PG8_LAS unsigned*)(lds + (bufoff) + ldsw + _i * 8192), 16, 0, 0); } while (0)
#define PG8_LDA(dst, b, h) do { _Pragma("unroll") for (int m = 0; m < 4; ++m) _Pragma("unroll") for (int k = 0; k < 2; ++k) dst[m][k] = *(const PG8_LAS bf16x8*)(lds + PG8_SA(b, h) + aoff + m * 2048 + k * 1024); } while (0)
#define PG8_LDB(dst, b, h) do { _Pragma("unroll") for (int n = 0; n < 2; ++n) _Pragma("unroll") for (int k = 0; k < 2; ++k) dst[n][k] = *(const PG8_LAS bf16x8*)(lds + PG8_SB(b, h) + boff + n * 2048 + k * 1024); } while (0)
#define PG8_MMA(ai, bj, At, Bt) do { __builtin_amdgcn_s_setprio(1); _Pragma("unroll") for (int m = 0; m < 4; ++m) _Pragma("unroll") for (int n = 0; n < 2; ++n) _Pragma("unroll") for (int k = 0; k < 2; ++k) \
        acc[ai][bj][m][n] = __builtin_amdgcn_mfma_f32_16x16x32_f16(Bt[n][k], At[m][k], acc[ai][bj][m][n], 0, 0, 0); __builtin_amdgcn_s_setprio(0); } while (0)
#define PG8_WAIT_V(n) asm volatile("s_waitcnt vmcnt(" #n ")" ::: "memory")
#define PG8_WAIT_L(n) asm volatile("s_waitcnt lgkmcnt(" #n ")" ::: "memory")
#define PG8_BAR __builtin_amdgcn_s_barrier()
#define PG8_SCHED __builtin_amdgcn_sched_barrier(0)
    Unit cur, nxt; int ui = 0;
    if (!S.next(0, cur)) return;
    f32x4 acc[2][2][4][2];
#pragma unroll
    for (int a = 0; a < 2; ++a)
#pragma unroll
        for (int b = 0; b < 2; ++b)
#pragma unroll
            for (int m = 0; m < 4; ++m)
#pragma unroll
                for (int n = 0; n < 2; ++n) acc[a][b][m][n] = (f32x4){0.f, 0.f, 0.f, 0.f};
    bf16x8 At[4][2], B0[2][2], B1[2][2];
    const char* cA = (const char*)g.A + (size_t)cur.pm * tstep; const char* cB = (const char*)g.Bt + (size_t)cur.pn * tstep;
    S.a_ready(cur);
    if constexpr (SP2) {
        PG8_STAGE(PG8_SB(0, 0), cB, voffB); PG8_STAGE(PG8_SB(0, 1), cB + hstep, voffB); PG8_STAGE(PG8_SA(0, 0), cA, voffA); PG8_STAGE(PG8_SA(0, 1), cA + hstep, voffA);
        if (wr == 1) PG8_BAR;
        PG8_WAIT_V(2); PG8_BAR;
        PG8_STAGE(PG8_SB(1, 0), cB + kstep, voffB); PG8_STAGE(PG8_SA(1, 0), cA + kstep, voffA); PG8_STAGE(PG8_SB(1, 1), cB + hstep + kstep, voffB);
        PG8_WAIT_V(6); PG8_BAR;
    } else {
        PG8_STAGE(PG8_SB(0, 0), cB, voffB); PG8_STAGE(PG8_SA(0, 0), cA, voffA); PG8_STAGE(PG8_SB(0, 1), cB + hstep, voffB); PG8_STAGE(PG8_SA(0, 1), cA + hstep, voffA);
        if (wr == 1) PG8_BAR;
        PG8_WAIT_V(4); PG8_BAR;
        PG8_STAGE(PG8_SB(1, 0), cB + kstep, voffB); PG8_STAGE(PG8_SA(1, 0), cA + kstep, voffA); PG8_STAGE(PG8_SB(1, 1), cB + hstep + kstep, voffB);
        PG8_WAIT_V(6); PG8_BAR;
    }
    for (;;) {
        const bool has_next = S.next(ui + 1, nxt);
        const char* nA = has_next ? (const char*)g.A + (size_t)nxt.pm * tstep : cA; const char* nB = has_next ? (const char*)g.Bt + (size_t)nxt.pn * tstep : cB;
        for (int t = 0; t < nt; t += 2) {
            const bool last = (t == nt - 2);
            const char* a1 = cA + (size_t)(t + 1) * kstep;
            const char* a2 = last ? nA : cA + (size_t)(t + 2) * kstep; const char* b2 = last ? nB : cB + (size_t)(t + 2) * kstep;
            const char* a3 = a2 + kstep; const char* b3 = b2 + kstep;
            if (last && has_next) S.a_ready(nxt);
            if constexpr (SP2) {
            PG8_LDB(B0, 0, 0); PG8_LDB(B1, 0, 1); PG8_SCHED; PG8_LDA(At, 0, 0); PG8_STAGE(PG8_SA(1, 1), a1 + hstep, voffA);
            PG8_WAIT_V(8); PG8_WAIT_L(0); PG8_BAR; PG8_MMA(0, 0, At, B0); PG8_MMA(0, 1, At, B1); PG8_BAR; PG8_SCHED;
            PG8_LDA(At, 0, 1); PG8_STAGE(PG8_SB(0, 0), b2, voffB); PG8_STAGE(PG8_SB(0, 1), b2 + hstep, voffB); PG8_STAGE(PG8_SA(0, 0), a2, voffA);
            PG8_WAIT_V(8); PG8_WAIT_L(0); PG8_BAR; PG8_MMA(1, 0, At, B0); PG8_MMA(1, 1, At, B1); PG8_BAR; PG8_SCHED;
            PG8_LDB(B0, 1, 0); PG8_LDB(B1, 1, 1); PG8_SCHED; PG8_LDA(At, 1, 0); PG8_STAGE(PG8_SA(0, 1), a2 + hstep, voffA);
            PG8_WAIT_V(8); PG8_WAIT_L(0); PG8_BAR; PG8_MMA(0, 0, At, B0); PG8_MMA(0, 1, At, B1); PG8_BAR; PG8_SCHED;
            PG8_LDA(At, 1, 1); PG8_STAGE(PG8_SB(1, 0), b3, voffB); PG8_STAGE(PG8_SB(1, 1), b3 + hstep, voffB); PG8_STAGE(PG8_SA(1, 0), a3, voffA);
            PG8_WAIT_V(8); PG8_WAIT_L(0); PG8_BAR; PG8_MMA(1, 0, At, B0); PG8_MMA(1, 1, At, B1); PG8_BAR; PG8_SCHED;
            } else {
            PG8_LDB(B0, 0, 0); PG8_SCHED; PG8_LDA(At, 0, 0); PG8_STAGE(PG8_SA(1, 1), a1 + hstep, voffA);
            PG8_WAIT_L(8); PG8_BAR; PG8_WAIT_L(0); PG8_MMA(0, 0, At, B0); PG8_BAR; PG8_SCHED;
            PG8_LDB(B1, 0, 1); PG8_STAGE(PG8_SB(0, 0), b2, voffB);
            PG8_BAR; PG8_WAIT_L(0); PG8_MMA(0, 1, At, B1); PG8_BAR;
            PG8_LDA(At, 0, 1); PG8_STAGE(PG8_SA(0, 0), a2, voffA);
            PG8_BAR; PG8_WAIT_L(0); PG8_MMA(1, 0, At, B0); PG8_BAR; PG8_SCHED;
            PG8_STAGE(PG8_SB(0, 1), b2 + hstep, voffB);
            PG8_WAIT_V(6); PG8_BAR; PG8_MMA(1, 1, At, B1); PG8_BAR;
            PG8_LDB(B0, 1, 0); PG8_SCHED; PG8_LDA(At, 1, 0); PG8_STAGE(PG8_SA(0, 1), a2 + hstep, voffA);
            PG8_WAIT_L(8); PG8_BAR; PG8_WAIT_L(0); PG8_MMA(0, 0, At, B0); PG8_BAR; PG8_SCHED;
            PG8_LDB(B1, 1, 1); PG8_STAGE(PG8_SB(1, 0), b3, voffB);
            PG8_BAR; PG8_WAIT_L(0); PG8_MMA(0, 1, At, B1); PG8_BAR;
            PG8_LDA(At, 1, 1); PG8_STAGE(PG8_SA(1, 0), a3, voffA);
            PG8_BAR; PG8_WAIT_L(0); PG8_MMA(1, 0, At, B0); PG8_BAR; PG8_SCHED;
            PG8_STAGE(PG8_SB(1, 1), b3 + hstep, voffB);
            PG8_WAIT_V(6); PG8_BAR; PG8_MMA(1, 1, At, B1); PG8_BAR;
            }
        }
        if constexpr (ALIGN_EPI) { if (wr == 0) PG8_BAR; }
        if constexpr (!Epi::AFTER_DRAIN) { E(acc, cur, wr, wc, fr, fq); S.done(cur); }
        if (!has_next) break;
#pragma unroll
        for (int a = 0; a < 2; ++a)
#pragma unroll
            for (int b = 0; b < 2; ++b)
#pragma unroll
                for (int m = 0; m < 4; ++m)
#pragma unroll
                    for (int n = 0; n < 2; ++n) acc[a][b][m][n] = (f32x4){0.f, 0.f, 0.f, 0.f};
        cur = nxt; cA = nA; cB = nB; ++ui;
        if constexpr (ALIGN_EPI) { if (wr == 1) PG8_BAR; }
    }
    PG8_WAIT_V(0);
    if constexpr (!ALIGN_EPI) { if (wr == 0) PG8_BAR; }
    PG8_BAR;
    if constexpr (Epi::AFTER_DRAIN) { E.fused(acc, cur, wr, wc, fr, fq, lds, wid, lane); S.done(cur); }
#undef PG8_SA
#undef PG8_SB
#undef PG8_STAGE
#undef PG8_LDA
#undef PG8_LDB
#undef PG8_MMA
#undef PG8_WAIT_V
#undef PG8_WAIT_L
#undef PG8_BAR
#undef PG8_SCHED
}
}
namespace pg8 {
struct EpiProj {
    static constexpr bool PERM = true, AFTER_DRAIN = false;
    f16* O; int ldc; PG8_LAS float* part;
    const float* g_fq; const float* g_fk; const float* g_nq; const float* g_nk;
    __device__ __forceinline__ void operator()(const f32x4 (&acc)[2][2][4][2], const Unit& u, int wr, int wc, int fr, int fq) const {
        const int row0 = u.pm * BM + wr * 64 + fr, col0 = u.pn * BM + wc * 32 + 8 * fq;
        const float* gain = nullptr;
        if (u.pn < 4) gain = g_fq; else if (u.pn < 8) gain = g_fk; else if (u.pn >= 12 && u.pn < 16) gain = g_nq; else if (u.pn == 17) gain = g_nk + 128; else if (u.pn == 18) gain = g_nk + 256;
        f32x4 gv[2] = {{1.f, 1.f, 1.f, 1.f}, {1.f, 1.f, 1.f, 1.f}};
        if (gain) {
#pragma unroll
            for (int ai = 0; ai < 2; ++ai)
#pragma unroll
                for (int m = 0; m < 4; ++m)
#pragma unroll
                    for (int bj = 0; bj < 2; ++bj) { const f32x4 v0 = acc[ai][bj][m][0], v1 = acc[ai][bj][m][1];
                        float s = (v0[0] * v0[0] + v0[1] * v0[1]) + (v0[2] * v0[2] + v0[3] * v0[3]) + (v1[0] * v1[0] + v1[1] * v1[1]) + (v1[2] * v1[2] + v1[3] * v1[3]);
                        s += __shfl_xor(s, 16); s += __shfl_xor(s, 32);
                        if (fq == 0) part[((ai * HALF + wr * 64 + m * 16 + fr) * 2 + bj) * 4 + wc] = s; }
            asm volatile("s_waitcnt lgkmcnt(0)" ::: "memory"); __builtin_amdgcn_s_barrier(); asm volatile("" ::: "memory");
            gv[0] = *(const f32x4*)(gain + wc * 32 + 8 * fq); gv[1] = *(const f32x4*)(gain + wc * 32 + 8 * fq + 4);
        }
#pragma unroll
        for (int ai = 0; ai < 2; ++ai)
#pragma unroll
            for (int m = 0; m < 4; ++m) { f16* rowp = O + (size_t)(row0 + ai * HALF + m * 16) * ldc + col0;
#pragma unroll
                for (int bj = 0; bj < 2; ++bj) { float rs = 1.f;
                    if (gain) { const f32x4 p4 = *(const PG8_LAS f32x4*)(part + ((ai * HALF + wr * 64 + m * 16 + fr) * 2 + bj) * 4);
                        rs = rsqrtf(((p4[0] + p4[1]) + (p4[2] + p4[3])) * (1.f / 128.f) + EPS); }
                    const f32x4 v0 = acc[ai][bj][m][0] * gv[0] * rs, v1 = acc[ai][bj][m][1] * gv[1] * rs;
                    h8 w; w[0] = (f16)v0[0]; w[1] = (f16)v0[1]; w[2] = (f16)v0[2]; w[3] = (f16)v0[3]; w[4] = (f16)v1[0]; w[5] = (f16)v1[1]; w[6] = (f16)v1[2]; w[7] = (f16)v1[3];
                    *(h8*)(rowp + bj * HALF) = w; }
                asm volatile("" ::: "memory"); }
        if (gain) { asm volatile("s_waitcnt lgkmcnt(0)" ::: "memory"); __builtin_amdgcn_s_barrier(); asm volatile("" ::: "memory"); }
    }
};
struct EpiGU {
    static constexpr bool PERM = true, AFTER_DRAIN = false;
    f16* O;
    __device__ __forceinline__ void operator()(const f32x4 (&acc)[2][2][4][2], const Unit& u, int wr, int wc, int fr, int fq) const {
        const int row0 = u.pm * BM + wr * 64 + fr, col0 = u.pn * HALF + wc * 32 + 8 * fq;
#pragma unroll
        for (int ai = 0; ai < 2; ++ai)
#pragma unroll
            for (int m = 0; m < 4; ++m) { h8 w;
#pragma unroll
                for (int n = 0; n < 2; ++n)
#pragma unroll
                    for (int e = 0; e < 4; ++e) { const float g = acc[ai][0][m][n][e], up = acc[ai][1][m][n][e];
                        w[n * 4 + e] = (f16)(g * __builtin_amdgcn_rcpf(1.f + __expf(-g)) * up); }
                *(h8*)(O + (size_t)(row0 + ai * HALF + m * 16) * DFF + col0) = w; }
    }
};
struct EpiRes {
    static constexpr bool PERM = false, AFTER_DRAIN = false;
    const float* base; float* out; const float* gate;
    __device__ __forceinline__ void operator()(const f32x4 (&acc)[2][2][4][2], const Unit& u, int wr, int wc, int fr, int fq) const {
        const int row0 = u.pm * BM + wr * 64 + fr, col0 = u.pn * BM + wc * 32 + 4 * fq;
        const float* gp = gate + (size_t)((u.pm * BM) / SEQ) * NMOD + col0;
        f32x4 gv[2][2];
#pragma unroll
        for (int bj = 0; bj < 2; ++bj)
#pragma unroll
            for (int n = 0; n < 2; ++n) gv[bj][n] = *(const f32x4*)(gp + bj * HALF + n * 16);
#pragma unroll
        for (int ai = 0; ai < 2; ++ai)
#pragma unroll
            for (int m = 0; m < 4; ++m) { const size_t off = (size_t)(row0 + ai * HALF + m * 16) * DM + col0;
#pragma unroll
                for (int bj = 0; bj < 2; ++bj)
#pragma unroll
                    for (int n = 0; n < 2; ++n) { const f32x4 bs = *(const f32x4*)(base + off + bj * HALF + n * 16);
                        *(f32x4*)(out + off + bj * HALF + n * 16) = bs + gv[bj][n] * acc[ai][bj][m][n]; } }
    }
};
}
#ifndef PG8_SP2
#define PG8_SP2 true
#endif
#ifndef PG8_ALIGN
#define PG8_ALIGN true
#endif
#define XB_TMO      128
#define XB_XCNT(j)  (256  + 64 * (j))
#define XB_XSUB(j)  (1280 + 64 * (j))
#define XB_XGEN(j)  (2304 + 64 * (j))
#define XB_TOP      3328
#define XB_TOPGEN   3392
#define XCD_BAR_WORDS 3456
#define XB_SPIN_CAP (1u << 18)

__device__ __forceinline__ unsigned xb_ld(unsigned* p)              { return __hip_atomic_load(p, __ATOMIC_RELAXED, __HIP_MEMORY_SCOPE_AGENT); }
__device__ __forceinline__ unsigned xb_add(unsigned* p, unsigned v) { return __hip_atomic_fetch_add(p, v, __ATOMIC_RELAXED, __HIP_MEMORY_SCOPE_AGENT); }
__device__ __forceinline__ unsigned xb_xcc_id() { return (unsigned)__builtin_amdgcn_s_getreg((3 << 11) | 20) & 0xFu; }
#define XB_SPIN(cond, bar) do { unsigned _sp = 0; while (cond) { __builtin_amdgcn_s_sleep(1); \
    if ((++_sp & 255u) == 0u) { if (xb_ld(&(bar)[XB_TMO])) break; if (_sp > XB_SPIN_CAP) { atomicAdd(&(bar)[XB_TMO], 1u); break; } } } } while (0)

struct XcdBarrier {
    unsigned* bar; unsigned x;
    volatile LAS unsigned* st;
};

__device__ __forceinline__ XcdBarrier xcd_barrier_post(unsigned* bar, volatile LAS unsigned* st) {
    XcdBarrier b; b.bar = bar; b.x = xb_xcc_id(); b.st = st;
    if (threadIdx.x == 0) (void)xb_add(&bar[XB_XCNT(b.x)], 1u);
    return b;
}
__device__ __forceinline__ void xcd_barrier_complete(unsigned* bar, unsigned x, unsigned& nloc, unsigned& nx) {
    const unsigned G = gridDim.x * gridDim.y * gridDim.z;
    unsigned sum, cnt, mine, sp = 0u;
    for (;;) {
        sum = 0u; cnt = 0u; mine = 0u;
#pragma unroll
        for (unsigned j = 0; j < 16; ++j) { const unsigned c = xb_ld(&bar[XB_XCNT(j)]); sum += c; cnt += (c > 0u) ? 1u : 0u; mine = (j == x) ? c : mine; }
        if (sum == G) break;
        __builtin_amdgcn_s_sleep(1);
        if ((++sp & 255u) == 0u) { if (xb_ld(&bar[XB_TMO])) break; if (sp > XB_SPIN_CAP) { atomicAdd(&bar[XB_TMO], 1u); break; } }
    }
    nloc = mine > 0u ? mine : 1u; nx = cnt > 0u ? cnt : 1u;
}

__device__ __forceinline__ void xcd_barrier(const XcdBarrier& b) {
    asm volatile("s_waitcnt vmcnt(0)" ::: "memory");
    __syncthreads();
    if (threadIdx.x == 0) {
        unsigned* bar = b.bar;
        __builtin_amdgcn_s_waitcnt(0);
        unsigned nloc = b.st[0], nx = b.st[1];
        if (nloc == 0u) { xcd_barrier_complete(bar, b.x, nloc, nx); b.st[0] = nloc; b.st[1] = nx; }
        const unsigned old = xb_add(&bar[XB_XSUB(b.x)], 1u);
        const unsigned gen = old / nloc;
        if (old + 1u == (gen + 1u) * nloc) {
            __builtin_amdgcn_fence(__ATOMIC_RELEASE, "agent");
            asm volatile("s_waitcnt vmcnt(0)" ::: "memory");
            const unsigned og = xb_add(&bar[XB_TOP], 1u);
            const unsigned tg = og / nx;
            if (og + 1u == (tg + 1u) * nx) xb_add(&bar[XB_TOPGEN], 1u);
            else XB_SPIN(xb_ld(&bar[XB_TOPGEN]) == tg, bar);
            __builtin_amdgcn_fence(__ATOMIC_ACQUIRE, "agent");
            xb_add(&bar[XB_XGEN(b.x)], 1u);
            asm volatile("s_waitcnt vmcnt(0)" ::: "memory");
        } else {
            XB_SPIN(xb_ld(&bar[XB_XGEN(b.x)]) == gen, bar);
            __builtin_amdgcn_fence(__ATOMIC_ACQUIRE, "agent");
            asm volatile("s_waitcnt vmcnt(0)" ::: "memory");
        }
    }
    __syncthreads();
}
__device__ __forceinline__ void compress_task(const Args& a, char* lds, int task) {
    const int tid = threadIdx.x, wid = __builtin_amdgcn_readfirstlane(tid >> 6), lane = tid & 63, l15 = lane & 15, lq = lane >> 4;
    unsigned char* ws = a.ws;
    const int ct = task & 7, kvh = (task >> 3) & 1, b = (task >> 4) & 3, wh = task >> 6;
    const f16* PROJ = (const f16*)(ws + WS_PROJ);
    const f16* W1T = (const f16*)(ws + WS_W1T) + (size_t)wh * 128 * 4096; const f16* W2T = (const f16*)(ws + WS_W2T) + (size_t)wh * 128 * 128;
    const float* B1 = (const float*)(ws + WS_B1) + wh * 128;
    const int col = (wh == 0 ? C_NK : C_NV) + kvh * 128;
    const int c = ct * 16 + l15;
    f32x4 acc[8];
#pragma unroll
    for (int n = 0; n < 8; ++n) acc[n] = (f32x4){0.f, 0.f, 0.f, 0.f};
    const f16* wbase = W1T + (size_t)l15 * 4096 + wid * 512 + lq * 8;
#pragma unroll 2
    for (int ks = 0; ks < 16; ++ks) {
        const int g = wid * 16 + ks;
        int tok = 16 * c + (g >> 2); tok = tok > SEQ - 1 ? SEQ - 1 : tok;
        const h8 av = *(const h8*)(PROJ + (size_t)(b * SEQ + tok) * NP + col + (g & 3) * 32 + lq * 8);
        h8 bv[8];
#pragma unroll
        for (int n = 0; n < 8; ++n) bv[n] = *(const h8*)(wbase + (size_t)n * 16 * 4096 + ks * 32);
#pragma unroll
        for (int n = 0; n < 8; ++n) acc[n] = __builtin_amdgcn_mfma_f32_16x16x32_f16(av, bv[n], acc[n], 0, 0, 0);
    }
    float* part = (float*)lds;
    f16* hid = (f16*)(lds + 65536);
    float* ssq = (float*)(lds + 65536 + 4096);
#pragma unroll
    for (int n = 0; n < 8; ++n)
#pragma unroll
        for (int i = 0; i < 4; ++i) part[(wid * 16 + 4 * lq + i) * 128 + n * 16 + l15] = acc[n][i];
    __syncthreads();
#pragma unroll
    for (int e = 0; e < 4; ++e) { const int idx = tid + e * NT, cc = idx & 127; float s = B1[cc];
#pragma unroll
        for (int w = 0; w < 8; ++w) s += part[w * 2048 + idx];
        hid[idx] = (f16)silu_f(s); }
    __syncthreads();
    f32x4 acc2 = {0.f, 0.f, 0.f, 0.f};
#pragma unroll
    for (int s = 0; s < 4; ++s) {
        const h8 av = *(const h8*)(hid + l15 * 128 + s * 32 + lq * 8);
        const h8 bv = *(const h8*)(W2T + (size_t)(wid * 16 + l15) * 128 + s * 32 + lq * 8);
        acc2 = __builtin_amdgcn_mfma_f32_16x16x32_f16(av, bv, acc2, 0, 0, 0);
    }
    float rs[4] = {1.f, 1.f, 1.f, 1.f};
    if (wh == 0) {
#pragma unroll
        for (int i = 0; i < 4; ++i) { float s = acc2[i] * acc2[i]; s += __shfl_xor(s, 1); s += __shfl_xor(s, 2); s += __shfl_xor(s, 4); s += __shfl_xor(s, 8);
            if (l15 == 0) ssq[wid * 16 + 4 * lq + i] = s; }
    }
    __syncthreads();
    if (wh == 0) {
        const float gn = a.in[I_NKG][wid * 16 + l15];
#pragma unroll
        for (int i = 0; i < 4; ++i) { float s = 0.f;
#pragma unroll
            for (int w = 0; w < 8; ++w) s += ssq[w * 16 + 4 * lq + i];
            rs[i] = rsqrtf(s * (1.f / 128.f) + EPS) * gn; }
    }
    f16* dst = (f16*)(ws + (wh == 0 ? WS_KC : WS_VC)) + (size_t)(b * 2 + kvh) * 128 * 128;
#pragma unroll
    for (int i = 0; i < 4; ++i) { const int cr = ct * 16 + 4 * lq + i; dst[(size_t)cr * 128 + wid * 16 + l15] = cr < NCMP ? (f16)(acc2[i] * rs[i]) : (f16)0.f; }
    __syncthreads();
}
namespace att {
constexpr int KVBLK = 64, SHM_K = 16384, SHM_V = 16384;
constexpr int L_V = 0, L_K = 32768, L_WSF = 65536, L_KB = 67584, L_TBL = 68096, L_SELM = 72192, L_UNION = 72448, L_TL = 72512, L_IMPH = 73728, L_CUM = 107520, L_END = 115712;
constexpr float C2 = LOG2E * SCALE, THR2 = 8.f * LOG2E;
#define KSWZ(row, colB) ((row) * 256 + ((colB) ^ (((row) & 7) << 4)))
#define SBAR() __builtin_amdgcn_sched_barrier(0)
__device__ __forceinline__ int v_st(int k, int c) { const int kk = (k & ~0xC) | ((k & 4) << 1) | ((k & 8) >> 1); return ((kk >> 3) * 4 + (c >> 5)) * 512 + ((kk & 7) * 32 + (c & 31)) * 2; }
__device__ __forceinline__ int v_rd_base(int lane) { return ((lane & 3) << 3) | (((lane >> 2) & 3) << 6) | (((lane >> 4) & 1) << 5) | (((lane >> 5) & 1) << 8); }
constexpr int v_rd_off(int d0, int ks, int half) { return d0 * 512 + ks * 4096 + half * 2048; }
__device__ __forceinline__ int crow(int r, int hi) { return (r & 3) + 8 * (r >> 2) + 4 * hi; }
__device__ __forceinline__ unsigned cvtpk(float lo, float hi) { h2 v; v.x = (f16)lo; v.y = (f16)hi; return __builtin_bit_cast(unsigned, v); }
typedef short s16x4 __attribute__((ext_vector_type(4)));

__device__ __forceinline__ void qkt(f32x16& p0, f32x16& p1, const char* K_lds, int r32, int hi, const h8* qr) {
    p0 = f32x16{}; p1 = f32x16{};
    const char* kb[4];
#pragma unroll
    for (int dd = 0; dd < 4; ++dd) kb[dd] = K_lds + KSWZ(r32, (dd * 16 + hi * 8) * 2);
#pragma unroll
    for (int d0 = 0; d0 < 8; ++d0) { const char* a = kb[d0 & 3] + (d0 >> 2) * 128;
        const h8 b0 = *reinterpret_cast<const h8*>(a);
        const h8 b1 = *reinterpret_cast<const h8*>(a + 32 * 256);
        p0 = __builtin_amdgcn_mfma_f32_32x32x16_f16(b0, qr[d0], p0, 0, 0, 0);
        p1 = __builtin_amdgcn_mfma_f32_32x32x16_f16(b1, qr[d0], p1, 0, 0, 0);
        if (d0 == 3) SBAR(); }
}
__device__ __forceinline__ void pv_tile(f32x16* o, int vb0, h8 pa0, h8 pa1, h8 pa2, h8 pa3) {
#define TRRD(dst, off) asm volatile("ds_read_b64_tr_b16 %0, %1 offset:%2" : "=&v"(dst) : "v"(vb0), "i"(off) : "memory")
#define PV_D0(d0) do { s16x4 l0, l1, l2, l3, g0, g1, g2, g3; constexpr int b_ = v_rd_off(d0, 0, 0); \
        TRRD(l0, b_); TRRD(g0, b_ + 2048); TRRD(l1, b_ + 4096); TRRD(g1, b_ + 6144); TRRD(l2, b_ + 8192); TRRD(g2, b_ + 10240); TRRD(l3, b_ + 12288); TRRD(g3, b_ + 14336); \
        asm volatile("s_waitcnt lgkmcnt(0)" ::: "memory"); SBAR(); \
        o[d0] = __builtin_amdgcn_mfma_f32_32x32x16_f16(pa0, __builtin_bit_cast(h8, (short __attribute__((ext_vector_type(8)))){l0[0], l0[1], l0[2], l0[3], g0[0], g0[1], g0[2], g0[3]}), o[d0], 0, 0, 0); \
        o[d0] = __builtin_amdgcn_mfma_f32_32x32x16_f16(pa1, __builtin_bit_cast(h8, (short __attribute__((ext_vector_type(8)))){l1[0], l1[1], l1[2], l1[3], g1[0], g1[1], g1[2], g1[3]}), o[d0], 0, 0, 0); \
        o[d0] = __builtin_amdgcn_mfma_f32_32x32x16_f16(pa2, __builtin_bit_cast(h8, (short __attribute__((ext_vector_type(8)))){l2[0], l2[1], l2[2], l2[3], g2[0], g2[1], g2[2], g2[3]}), o[d0], 0, 0, 0); \
        o[d0] = __builtin_amdgcn_mfma_f32_32x32x16_f16(pa3, __builtin_bit_cast(h8, (short __attribute__((ext_vector_type(8)))){l3[0], l3[1], l3[2], l3[3], g3[0], g3[1], g3[2], g3[3]}), o[d0], 0, 0, 0); } while (0)
    PV_D0(0); PV_D0(1); PV_D0(2); PV_D0(3);
#undef PV_D0
#undef TRRD
}
__device__ __forceinline__ void partialSM(f32x16& p0, f32x16& p1, float& m_reg, float& mn, float& alpha) {
    float pmax = p0[0];
#pragma unroll
    for (int r = 1; r < 16; ++r) pmax = fmaxf(pmax, p0[r]);
#pragma unroll
    for (int r = 0; r < 16; ++r) pmax = fmaxf(pmax, p1[r]);
    { auto rr = __builtin_amdgcn_permlane32_swap(__float_as_uint(pmax), __float_as_uint(pmax), false, false);
      pmax = fmaxf(__uint_as_float(rr[0]), __uint_as_float(rr[1])); }
    if (__builtin_expect(__all((pmax - m_reg) <= THR2), 1)) { mn = m_reg; alpha = 1.f; }
    else { mn = fmaxf(m_reg, pmax); alpha = __builtin_amdgcn_exp2f(m_reg - mn); m_reg = mn; }
#pragma unroll
    for (int r = 0; r < 16; ++r) p0[r] = __builtin_amdgcn_exp2f(p0[r] - mn);
}
__device__ __forceinline__ void finishSM(f32x16& p0, f32x16& p1, float mn, float alpha, float& l_reg, h8& pa0, h8& pa1, h8& pa2, h8& pa3) {
#pragma unroll
    for (int r = 0; r < 16; ++r) p1[r] = __builtin_amdgcn_exp2f(p1[r] - mn);
    float ps = 0;
#pragma unroll
    for (int r = 0; r < 16; ++r) ps += p0[r];
#pragma unroll
    for (int r = 0; r < 16; ++r) ps += p1[r];
    { auto rr = __builtin_amdgcn_permlane32_swap(__float_as_uint(ps), __float_as_uint(ps), false, false);
      ps = __uint_as_float(rr[0]) + __uint_as_float(rr[1]); }
    l_reg = l_reg * alpha + ps;
#define PK4(P, B_, OUT) do { unsigned a0 = cvtpk(P[B_+0], P[B_+1]), a1 = cvtpk(P[B_+2], P[B_+3]); \
        unsigned b0 = cvtpk(P[B_+4], P[B_+5]), b1 = cvtpk(P[B_+6], P[B_+7]); \
        auto r0 = __builtin_amdgcn_permlane32_swap(a0, b0, false, false); auto r1 = __builtin_amdgcn_permlane32_swap(a1, b1, false, false); \
        u32x4 w = {r0[0], r1[0], r0[1], r1[1]}; OUT = __builtin_bit_cast(h8, w); } while (0)
    PK4(p0, 0, pa0); PK4(p0, 8, pa1); PK4(p1, 0, pa2); PK4(p1, 8, pa3);
#undef PK4
}
__device__ __forceinline__ void mask_tile(f32x16& p0, f32x16& p1, int dq, unsigned W) {
    const float NEG = -__builtin_inff();
#pragma unroll
    for (int r = 0; r < 16; ++r) { const int c = (r & 3) + 8 * (r >> 2);
        if ((unsigned)(dq - c) >= W) p0[r] = NEG;
        if ((unsigned)(dq - c - 32) >= W) p1[r] = NEG; }
}
__device__ __forceinline__ void t5_bias(f32x16& p0, f32x16& p1, int dq, const float* tb) {
#pragma unroll
    for (int r = 0; r < 16; ++r) { const int c = (r & 3) + 8 * (r >> 2);
        int d0 = dq - c, d1 = dq - c - 32;
        d0 = d0 < 0 ? 0 : (d0 > 127 ? 127 : d0); d1 = d1 < 0 ? 0 : (d1 > 127 ? 127 : d1);
        p0[r] += tb[d0]; p1[r] += tb[d1];
        if ((r & 3) == 3) SBAR(); }
}

enum { M_FOX = 0, M_SEL = 1, M_WIN = 2, M_CMP = 3 };
struct Run {
    const f16* K; const f16* V; int ldk;
    const float* kbias;
    int P0;
    int ntiles;
    f16* O;
};

template <int MODE>
__device__ __forceinline__ void run_tiles(const Run R, char* lds, const h8 (&qr)[8], int qlo, const float* tb, unsigned selrow, const int tid_in) {
    int tid = tid_in; asm volatile("" : "+v"(tid));
    const int wid = __builtin_amdgcn_readfirstlane(tid >> 6), lane = tid & 63, r32 = lane & 31, hi = lane >> 5;
    char* V_lds = lds + L_V; char* K_lds = lds + L_K;
    float* wsf = (float*)(lds + L_WSF) + wid * 64; float* li_l = wsf, * al_l = wsf + 32;
    const int* TL = (const int*)(lds + L_TL);
    const int vb0 = (int)(uintptr_t)V_lds + v_rd_base(lane);
    float m_reg = -1e30f, l_reg = 0.f; f32x16 o[4] = {};
    const int NTL = R.ntiles;
    int koff[2], voff[2];
#pragma unroll
    for (int i = 0; i < 2; ++i) { const int q = (wid * 2 + i) * 64 + lane;
        { const int row = q >> 4, ch = (q & 15) ^ (row & 7); koff[i] = row * R.ldk + ch * 8; }
        { const int sub = q >> 5, r16 = q & 31, kk = (sub >> 2) * 8 + (r16 >> 2), c = (sub & 3) * 32 + (r16 & 3) * 8;
          const int k = (kk & ~0xC) | ((kk & 4) << 1) | ((kk & 8) >> 1); voff[i] = k * R.ldk + c; } }
#define ISSUE(j, bf) do { const f16* kt_ = R.K + (size_t)((j) * KVBLK) * R.ldk; const f16* vt_ = R.V + (size_t)((j) * KVBLK) * R.ldk; \
        _Pragma("unroll") for (int i_ = 0; i_ < 2; ++i_) { \
            __builtin_amdgcn_global_load_lds((const unsigned*)(kt_ + koff[i_]), (LAS unsigned*)(uintptr_t)(unsigned)((int)(uintptr_t)K_lds + (bf) * SHM_K + (wid * 2 + i_) * 1024), 16, 0, 0); \
            __builtin_amdgcn_global_load_lds((const unsigned*)(vt_ + voff[i_]), (LAS unsigned*)(uintptr_t)(unsigned)((int)(uintptr_t)V_lds + (bf) * SHM_V + (wid * 2 + i_) * 1024), 16, 0, 0); } \
        } while (0)
    if (NTL > 0) ISSUE(TL[0], 0);
#pragma unroll 1
    for (int t = 0; t < NTL; ++t) {
        const int buf = t & 1, j = TL[t];
        asm volatile("s_waitcnt vmcnt(0)" ::: "memory");
        __syncthreads();
        if (t + 1 < NTL) ISSUE(TL[t + 1], buf ^ 1);
        f32x16 p0, p1;
        const int kb_ = (MODE == M_CMP) ? 0 : j * KVBLK;
        bool act = true;
        if (MODE == M_SEL) act = __any((selrow >> j) & 1u) != 0;
        if (MODE == M_WIN) act = (kb_ <= qlo + 31) && (kb_ + KVBLK - 1 >= qlo - (WIN - 1));
        if (MODE == M_FOX || MODE == M_SEL) act = act && (kb_ <= qlo + 31);
        if (act) {
            qkt(p0, p1, K_lds + buf * SHM_K, r32, hi, qr);
            if (MODE == M_FOX) {
                const float* kbp = (const float*)(lds + L_CUM) + kb_ + 4 * hi;
#pragma unroll
                for (int g = 0; g < 4; ++g) { const f32x4 b0 = *(const f32x4*)(kbp + 8 * g), b1 = *(const f32x4*)(kbp + 32 + 8 * g);
#pragma unroll
                    for (int i = 0; i < 4; ++i) { p0[4 * g + i] = fmaf(p0[4 * g + i], C2, b0[i]); p1[4 * g + i] = fmaf(p1[4 * g + i], C2, b1[i]); } }
                if (kb_ + KVBLK - 1 > qlo) mask_tile(p0, p1, qlo + r32 - 4 * hi - kb_, 0x7fffffffu);
            } else if (MODE == M_CMP) {
#pragma unroll
                for (int r = 0; r < 16; ++r) { p0[r] *= C2; p1[r] *= C2; }
                const int dq3 = qlo + r32 - 31 - 16 * (j * 64 + 4 * hi);
                const float NEG = -__builtin_inff();
                const bool near = (qlo - 31 - 16 * (j * 64 + 63)) < 113;
#pragma unroll
                for (int r = 0; r < 16; ++r) { const int c = (r & 3) + 8 * (r >> 2); const int d0 = dq3 - 16 * c, d1 = d0 - 512;
                    if (near) { p0[r] += tb[d0 < 0 ? 0 : (d0 > 127 ? 127 : d0)]; p1[r] += tb[d1 < 0 ? 0 : (d1 > 127 ? 127 : d1)]; }
                    if (d0 < 0) p0[r] = NEG; if (d1 < 0) p1[r] = NEG;
                    if ((r & 3) == 3) SBAR(); }
            } else {
#pragma unroll
                for (int r = 0; r < 16; ++r) { p0[r] *= C2; p1[r] *= C2; }
                const int dq = qlo + r32 - 4 * hi - kb_;
                if (qlo - (kb_ + KVBLK - 1) < 113) t5_bias(p0, p1, dq, tb);
                if (MODE == M_SEL) { if (kb_ + KVBLK - 1 > qlo) mask_tile(p0, p1, dq, 0x7fffffffu);
                    if (!((selrow >> j) & 1u)) { const float NEG = -__builtin_inff();
#pragma unroll
                        for (int r = 0; r < 16; ++r) { p0[r] = NEG; p1[r] = NEG; } } }
                else { if (kb_ + KVBLK - 1 > qlo || kb_ <= qlo + 31 - WIN) mask_tile(p0, p1, dq, (unsigned)WIN); }
            }
            float mn, alpha; h8 pa0, pa1, pa2, pa3;
            partialSM(p0, p1, m_reg, mn, alpha);
            finishSM(p0, p1, mn, alpha, l_reg, pa0, pa1, pa2, pa3);
            if (__any(alpha < 1.f)) { if (hi == 0) al_l[r32] = alpha; asm volatile("s_waitcnt lgkmcnt(0)" ::: "memory");
#pragma unroll
                for (int d_ = 0; d_ < 4; ++d_)
#pragma unroll
                    for (int r = 0; r < 16; ++r) o[d_][r] *= al_l[crow(r, hi)]; }
            SBAR();
            pv_tile(o, vb0 + buf * SHM_V, pa0, pa1, pa2, pa3);
        }
    }
#undef ISSUE
    if (hi == 0) li_l[r32] = l_reg; asm volatile("s_waitcnt lgkmcnt(0)" ::: "memory");
    f16* Ow = R.O + (size_t)(qlo - R.P0) * 1024;
#pragma unroll
    for (int r = 0; r < 16; ++r) { const int orow = crow(r, hi); const float lv = li_l[orow]; const float rl = lv > 0.f ? __builtin_amdgcn_rcpf(lv) : 0.f;
#pragma unroll
        for (int d0 = 0; d0 < 4; ++d0) { const float v = o[d0][r] * rl; const float vn = __shfl_xor(v, 1);
            if ((r32 & 1) == 0) *(unsigned*)(Ow + (size_t)orow * 1024 + d0 * 32 + r32) = cvtpk(v, vn); } }
    __syncthreads();
}

__device__ __forceinline__ int fill_tiles_range(char* lds, int j_lo, int j_hi, int tid) {
    int* TL = (int*)(lds + L_TL);
    if (tid < j_hi - j_lo) TL[tid] = j_lo + tid;
    __syncthreads();
    return j_hi - j_lo;
}

__device__ __forceinline__ void fox_unit(const Args& a, char* lds, int b, int h, int qt) {
    int tid_ = threadIdx.x; asm volatile("" : "+v"(tid_));
    const int tid = tid_, wid = __builtin_amdgcn_readfirstlane(tid >> 6), lane = tid & 63, r32 = lane & 31, hi = lane >> 5;
    unsigned char* wsb = a.ws; asm volatile("" : "+s"(wsb));
    const f16* PROJ = (const f16*)(wsb + WS_PROJ);
    const int P0 = qt * 256, qlo = P0 + wid * 32;
    h8 qr[8];
    { const f16* qp = PROJ + (size_t)(b * SEQ + qlo + r32) * NP + C_FQ + h * 128 + hi * 8;
#pragma unroll
      for (int d0 = 0; d0 < 8; ++d0) qr[d0] = *(const h8*)(qp + d0 * 16); }
    { float* cumL = (float*)(lds + L_CUM); float* wtot = (float*)(lds + L_KB);
      const int need = P0 + 256; const float fb = a.in[I_FB][h];
      float v[4]; float run = 0.f;
#pragma unroll
      for (int i = 0; i < 4; ++i) { const int t = tid * 4 + i; float ls = 0.f;
          if (t < need) { const float x = (float)PROJ[(size_t)(b * SEQ + t) * NP + C_FF + h] + fb; ls = fminf(x, 0.f) - log1pf(__expf(-fabsf(x))); }
          run += ls; v[i] = run; }
      float incl = run;
#pragma unroll
      for (int o_ = 1; o_ < 64; o_ <<= 1) { const float n_ = __shfl_up(incl, o_); if (lane >= o_) incl += n_; }
      if (lane == 63) wtot[wid] = incl;
      __syncthreads();
      float base = incl - run;
      for (int w = 0; w < wid; ++w) base += wtot[w];
      if (tid * 4 < need) { f32x4 o4; o4[0] = -(v[0] + base) * LOG2E; o4[1] = -(v[1] + base) * LOG2E; o4[2] = -(v[2] + base) * LOG2E; o4[3] = -(v[3] + base) * LOG2E;
          *(f32x4*)(cumL + tid * 4) = o4; }
      __syncthreads(); }
    Run R; R.K = PROJ + (size_t)(b * SEQ) * NP + C_FK + h * 128; R.V = PROJ + (size_t)(b * SEQ) * NP + C_FV + h * 128; R.ldk = NP;
    R.kbias = nullptr; R.P0 = P0;
    R.O = (f16*)(wsb + WS_OF) + (size_t)(b * SEQ + P0) * 1024 + h * 128;
    R.ntiles = fill_tiles_range(lds, 0, (P0 + 255) / KVBLK + 1, tid);
    run_tiles<M_FOX>(R, lds, qr, qlo, nullptr, 0u, tid);
}

__device__ __forceinline__ unsigned topk_mask32(const float (&impin)[32], int t) {
    float v[32]; const int cur = t >> 6;
#pragma unroll
    for (int j = 0; j < 32; ++j) { float x = impin[j]; if (j == 0 || j == cur || j == cur - 1) x = 1e6f; if (j > cur) x = -__builtin_inff(); v[j] = x; }
    unsigned mask = 0u;
#pragma unroll 1
    for (int it = 0; it < NSEL; ++it) { float best = -__builtin_inff(); int bi = -1;
#pragma unroll
        for (int j = 0; j < 32; ++j) if (v[j] > best) { best = v[j]; bi = j; }
        if (bi < 0) break;
        mask |= 1u << bi;
#pragma unroll
        for (int j = 0; j < 32; ++j) if (j == bi) v[j] = -__builtin_inff(); }
    return mask;
}
__device__ __forceinline__ void nsa_unit(const Args& a, char* lds, int b, int kvh, int qt) {
    int tid_ = threadIdx.x; asm volatile("" : "+v"(tid_));
    const int tid = tid_, wid = __builtin_amdgcn_readfirstlane(tid >> 6), lane = tid & 63, r32 = lane & 31, hi = lane >> 5;
    unsigned char* wsb = a.ws; asm volatile("" : "+s"(wsb));
    const f16* PROJ = (const f16*)(wsb + WS_PROJ);
    const int P0 = qt * 64, qlo = P0 + (wid >> 2) * 32, g4 = wid & 3, hq = kvh * 4 + g4;
    const float* tb = (const float*)(lds + L_TBL) + hq * 128;
    h8 qr[8];
    { const f16* qp = PROJ + (size_t)(b * SEQ + qlo + r32) * NP + C_NQ + hq * 128 + hi * 8;
#pragma unroll
      for (int d0 = 0; d0 < 8; ++d0) qr[d0] = *(const h8*)(qp + d0 * 16); }
    const f16* KC = (const f16*)(wsb + WS_KC) + (size_t)(b * 2 + kvh) * 128 * 128; const f16* VC = (const f16*)(wsb + WS_VC) + (size_t)(b * 2 + kvh) * 128 * 128;
#ifndef NSA_SKIP_A
    {
        char* K_lds = lds + L_K;
        const int sr = tid >> 4, sc = (tid & 15) * 8, kws = KSWZ(sr, sc * 2);
#pragma unroll
        for (int T = 0; T < 2; ++T) { *(h8*)(K_lds + T * SHM_K + kws) = *(const h8*)(KC + (size_t)(T * 64 + sr) * 128 + sc);
            *(h8*)(K_lds + T * SHM_K + kws + 32 * 256) = *(const h8*)(KC + (size_t)(T * 64 + 32 + sr) * 128 + sc); }
        __syncthreads();
        f32x16 x[4];
        qkt(x[0], x[1], K_lds, r32, hi, qr); qkt(x[2], x[3], K_lds + SHM_K, r32, hi, qr);
        const float NEG = -__builtin_inff();
        float mx = NEG;
#pragma unroll
        for (int T = 0; T < 2; ++T) { const int dq3 = qlo + r32 - 31 - 16 * (T * 64 + 4 * hi);
#pragma unroll
            for (int r = 0; r < 16; ++r) { const int c = (r & 3) + 8 * (r >> 2); const int d0 = dq3 - 16 * c, d1 = d0 - 512;
                float v0 = x[2 * T][r] * C2 + tb[d0 < 0 ? 0 : (d0 > 127 ? 127 : d0)], v1 = x[2 * T + 1][r] * C2 + tb[d1 < 0 ? 0 : (d1 > 127 ? 127 : d1)];
                if (d0 < 0) v0 = NEG; if (d1 < 0) v1 = NEG;
                x[2 * T][r] = v0; x[2 * T + 1][r] = v1; mx = fmaxf(mx, fmaxf(v0, v1)); } }
        mx = fmaxf(mx, __shfl_xor(mx, 32));
        const float mref = mx == NEG ? 0.f : mx;
        float sum = 0.f;
#pragma unroll
        for (int q = 0; q < 4; ++q)
#pragma unroll
            for (int r = 0; r < 16; ++r) { const float e = __builtin_amdgcn_exp2f(x[q][r] - mref); x[q][r] = e; sum += e; }
        sum += __shfl_xor(sum, 32);
        const float inv = sum > 0.f ? 1.f / sum : 0.f;
        float own[16], cout[16], cin[16];
#pragma unroll
        for (int q = 0; q < 4; ++q)
#pragma unroll
            for (int g = 0; g < 4; ++g) { const float e0 = x[q][4 * g], e1 = x[q][4 * g + 1], e2 = x[q][4 * g + 2], e3 = x[q][4 * g + 3];
                own[4 * q + g] = (2.f * (e0 + e1 + e2) + e3) * inv; cout[4 * q + g] = e3 * inv; }
#pragma unroll
        for (int k = 0; k < 16; ++k) cin[k] = __shfl_xor(cout[k], 32);
        float* IMPH = (float*)(lds + L_IMPH) + (size_t)(g4 * 64 + (wid >> 2) * 32 + r32) * 33;
#pragma unroll
        for (int k = 0; k < 16; ++k) { const float ci = hi ? cin[k] : (k > 0 ? cin[k - 1] : 0.f);
            const int q = k >> 2, g = k & 3, j = 16 * (q >> 1) + 8 * (q & 1) + 2 * g + hi;
            IMPH[j] = own[k] + ci; }
        __syncthreads();
        if (tid < 64) { const float* ip = (const float*)(lds + L_IMPH) + tid * 33; float imp[32];
#pragma unroll
            for (int j = 0; j < 32; ++j) imp[j] = ((ip[j] + ip[64 * 33 + j]) + ip[2 * 64 * 33 + j]) + ip[3 * 64 * 33 + j];
            unsigned m = topk_mask32(imp, P0 + tid);
            ((unsigned*)(lds + L_SELM))[tid] = m;
#pragma unroll
            for (int o_ = 1; o_ < 64; o_ <<= 1) m |= __shfl_xor(m, o_);
            if (tid == 0) *(unsigned*)(lds + L_UNION) = m; }
        __syncthreads();
    }
#endif
    const unsigned selrow = ((const unsigned*)(lds + L_SELM))[(wid >> 2) * 32 + r32];
    const unsigned uni = *(const unsigned*)(lds + L_UNION);
    Run R; R.kbias = nullptr; R.P0 = P0;
    const size_t obase = (size_t)(b * SEQ + P0) * 1024 + hq * 128;
    R.K = KC; R.V = VC; R.ldk = 128; R.O = (f16*)(wsb + WS_OC) + obase; R.ntiles = fill_tiles_range(lds, 0, 2, tid);
#ifndef NSA_SKIP_CMP
    run_tiles<M_CMP>(R, lds, qr, qlo, tb, 0u, tid);
#endif
    { int* TL = (int*)(lds + L_TL);
      if (tid == 0) { int n = 0; for (int j = 0; j < 32; ++j) if ((uni >> j) & 1u) TL[n++] = j; TL[39] = n; }
      __syncthreads(); }
    R.K = PROJ + (size_t)(b * SEQ) * NP + C_NK + 256 + kvh * 128; R.V = PROJ + (size_t)(b * SEQ) * NP + C_NV + 256 + kvh * 128; R.ldk = NP;
    R.O = (f16*)(wsb + WS_OS) + obase; R.ntiles = ((const int*)(lds + L_TL))[39];
#ifndef NSA_SKIP_SEL
    run_tiles<M_SEL>(R, lds, qr, qlo, tb, selrow, tid);
#endif
    { int jl = (P0 - (WIN - 1)); jl = jl > 0 ? jl / KVBLK : 0;
      R.K = PROJ + (size_t)(b * SEQ) * NP + C_NK + 512 + kvh * 128; R.V = PROJ + (size_t)(b * SEQ) * NP + C_NV + 512 + kvh * 128;
      R.O = (f16*)(wsb + WS_OW) + obase; R.ntiles = fill_tiles_range(lds, jl, (P0 + 63) / KVBLK + 1, tid);
#ifndef NSA_SKIP_WIN
      run_tiles<M_WIN>(R, lds, qr, qlo, tb, 0u, tid);
#endif
    }
}

__device__ __forceinline__ void attn_phase(const Args& a, char* lds, int bid, int nblk) {
    { const float* TBLR = (const float*)(a.ws + WS_TBL) + 1024; float* t = (float*)(lds + L_TBL);
      for (int i = threadIdx.x; i < 1024; i += NT) t[i] = TBLR[i] * LOG2E; }
    __syncthreads();
    for (int i = bid; i < 256; i += nblk) {
        const int qt_f = i & 7, k = (i >> 3) & 3, bh_f = i >> 3, rest = i >> 5, qt_n = 31 - 4 * qt_f - k;
        fox_unit(a, lds, bh_f >> 3, bh_f & 7, qt_f);
        nsa_unit(a, lds, rest >> 1, rest & 1, qt_n);
    }
}
#undef KSWZ
#undef SBAR
}
constexpr int LDS_BYTES = 147456;
constexpr int LDSCTL_OFF = 131072, MISC_OFF = LDSCTL_OFF + 320;
constexpr int CW_BAR = 4096;
constexpr int N_PHASES = 10;

__device__ __forceinline__ void gemm_stage(const Args& a, LAS unsigned char* lds, int stage) {
    unsigned char* ws = a.ws; const float* MOD = (const float*)(ws + WS_MOD);
    pg8::StaticOrder S;
    if (stage == 2) { pg8::Gemm g{(const f16*)(ws + WS_H), (const f16*)(ws + WS_WIN), NTOK, NP, DM}; S.init(NTOK, NP, gridDim.x, blockIdx.x);
        pg8::EpiProj E{(f16*)(ws + WS_PROJ), NP, (LAS float*)(lds + LDSCTL_OFF + 1024), a.in[I_FQG], a.in[I_FKG], a.in[I_NQG], a.in[I_NKG]}; pg8::gemm_phase<pg8::EpiProj, pg8::StaticOrder, PG8_ALIGN, PG8_SP2>(lds, g, S, E); }
    else if (stage == 6) { pg8::Gemm g{(const f16*)(ws + WS_H), (const f16*)(ws + WS_WOUT), NTOK, DM, DM}; S.init(NTOK, DM, gridDim.x, blockIdx.x);
        pg8::EpiRes E{a.in[I_X], (float*)(ws + WS_OF), MOD + 2 * DM}; pg8::gemm_phase<pg8::EpiRes, pg8::StaticOrder, PG8_ALIGN, PG8_SP2>(lds, g, S, E); }
    else if (stage == 8) { pg8::Gemm g{(const f16*)(ws + WS_H), (const f16*)(ws + WS_WGU), NTOK, NGU, DM}; S.init(NTOK, NGU, gridDim.x, blockIdx.x);
        pg8::EpiGU E{(f16*)(ws + WS_PROJ)}; pg8::gemm_phase<pg8::EpiGU, pg8::StaticOrder, PG8_ALIGN, PG8_SP2>(lds, g, S, E); }
    else { pg8::Gemm g{(const f16*)(ws + WS_PROJ), (const f16*)(ws + WS_WDN), NTOK, DM, DFF}; S.init(NTOK, DM, gridDim.x, blockIdx.x);
        pg8::EpiRes E{(const float*)(ws + WS_OF), a.out, MOD + 5 * DM}; pg8::gemm_phase<pg8::EpiRes, pg8::StaticOrder, PG8_ALIGN, PG8_SP2>(lds, g, S, E); }
}

__global__ void __launch_bounds__(NT, 2) k_mega(Args a) {
    extern __shared__ __attribute__((aligned(16))) unsigned char lds_raw[];
    LAS char* lds = (LAS char*)lds_raw;
    const int bid = blockIdx.x, nblk = gridDim.x, tid = threadIdx.x;
    for (int u = tid; u < (LDS_BYTES - LDSCTL_OFF) / 4; u += NT) ((LAS unsigned*)(lds + LDSCTL_OFF))[u] = 0u;
    __syncthreads();
    unsigned* ctl = (unsigned*)(a.ws + WS_CTL);
    XcdBarrier bar = xcd_barrier_post(ctl + CW_BAR + a.li * XCD_BAR_WORDS, (volatile LAS unsigned*)(lds + MISC_OFF) + 8);
    const int lo = a.ph_lo, hi = a.ph_hi;
#define IN(k) (lo <= (k) && (k) < hi)
#define SEAM(k) do { if (IN(k) && IN((k) + 1)) xcd_barrier(bar); } while (0)
#ifndef REPEAT_PHASE
#define REPEAT_PHASE -1
#endif
#define REP(k) for (int rep_ = 0; rep_ < ((k) == REPEAT_PHASE ? 2 : 1); ++rep_, ((k) == REPEAT_PHASE && rep_ == 1 ? xcd_barrier(bar) : (void)0))
    if (IN(0)) REP(0) { stage_prep(a, bid, nblk, lds); } SEAM(0);
    if (IN(1)) REP(1) { stage_norm(a, bid, nblk, lds, 0); } SEAM(1);
    if (IN(2)) REP(2) { gemm_stage(a, (LAS unsigned char*)lds_raw, 2); } SEAM(2);
    if (IN(3)) REP(3) {
#if !NAIVE_ATTN
        for (int task = bid; task < 128; task += nblk) compress_task(a, (char*)lds_raw, task);
#endif
        } SEAM(3);
    if (IN(4)) REP(4) {
#if !NAIVE_ATTN
        att::attn_phase(a, (char*)lds_raw, bid, nblk);
#endif
    } SEAM(4);
    if (IN(5)) REP(5) { stage_ynorm(a, bid, nblk); } SEAM(5);
    if (IN(6)) REP(6) { gemm_stage(a, (LAS unsigned char*)lds_raw, 6); } SEAM(6);
    if (IN(7)) REP(7) { stage_norm(a, bid, nblk, lds, 1); } SEAM(7);
    if (IN(8)) REP(8) { gemm_stage(a, (LAS unsigned char*)lds_raw, 8); } SEAM(8);
    if (IN(9)) REP(9) { gemm_stage(a, (LAS unsigned char*)lds_raw, 9); }
#undef IN
#undef SEAM
}

extern "C" void kernel_launch(void* const* d_in, const int* in_sizes, int n_in, void* d_out, int out_size, void* d_ws, size_t ws_size, hipStream_t stream) {
    static int grid = 0;
    if (grid == 0) {
        if (n_in != 21 || out_size != NTOK * DM || ws_size < WS_END) { fprintf(stderr, "kernel_launch: unexpected problem (n_in %d out %d ws %zu)\n", n_in, out_size, ws_size); grid = -1; return; }
        int dev = 0, cus = 0, per_cu = 0;
        hipGetDevice(&dev); hipDeviceGetAttribute(&cus, hipDeviceAttributeMultiprocessorCount, dev);
        hipFuncSetAttribute((const void*)k_mega, hipFuncAttributeMaxDynamicSharedMemorySize, LDS_BYTES);
        if (hipOccupancyMaxActiveBlocksPerMultiprocessor(&per_cu, (const void*)k_mega, NT, LDS_BYTES) != hipSuccess || per_cu < 1) { fprintf(stderr, "kernel_launch: occupancy query says %d blocks per CU\n", per_cu); per_cu = 1; }
        (void)hipGetLastError();
        grid = (cus > 0 ? cus : 256) * 1;
    }
    if (grid < 0) return;
    hipMemsetAsync((char*)d_ws + WS_CTL, 0, CTL_BYTES, stream);
    Args a{};
    for (int i = 0; i < 21; ++i) a.in[i] = (const float*)d_in[i];
    a.out = (float*)d_out; a.ws = (unsigned char*)d_ws;
#define MEGA(lo_, hi_, li_) do { a.ph_lo = (lo_); a.ph_hi = (hi_); a.li = (li_); hipLaunchKernelGGL(k_mega, dim3(grid), dim3(NT), LDS_BYTES, stream, a); } while (0)
#if NAIVE_ATTN
    MEGA(0, 3, 0);
    hipLaunchKernelGGL(naive_compress, dim3(2048), dim3(128), 0, stream, a);
    MEGA(3, 4, 1);
    hipLaunchKernelGGL(naive_fox, dim3(256), dim3(256), 0, stream, a);
    hipLaunchKernelGGL(naive_cmp, dim3(256), dim3(256), 0, stream, a);
    hipLaunchKernelGGL(naive_topk, dim3(NTOK * 2 / 256), dim3(256), 0, stream, a);
    hipLaunchKernelGGL(naive_selwin, dim3(256), dim3(256), 0, stream, a);
    MEGA(5, 10, 2);
#elif PER_PHASE
    for (int p = 0; p < N_PHASES; ++p) MEGA(p, p + 1, 0);
#else
    MEGA(0, N_PHASES, 0);
#endif
#undef MEGA
}
```
